# Optimizing an MI355X kernel written in HIP

```python
import math
import jax, jax.numpy as jnp
from jax import lax
import numpy as np

D_MODEL = 2048
BATCH = 1
SEQ = 16384
DEPTH = 2

N_A_LAYERS = DEPTH // 2
N_B_LAYERS = DEPTH - N_A_LAYERS
EPS = 1e-6

GLA_HEADS = 4
GLA_KEY_DIM = D_MODEL // 2
GLA_VAL_DIM = D_MODEL
GLA_HEAD_K = GLA_KEY_DIM // GLA_HEADS
GLA_HEAD_V = GLA_VAL_DIM // GLA_HEADS
GLA_GATE_RANK = 16
GLA_GATE_NORMALIZER = 16.0
GLA_CHUNK = 64

MOBA_HEADS = 16
MOBA_HEAD_DIM = D_MODEL // MOBA_HEADS
MOBA_BLOCK = 256
MOBA_TOPK = 3
MOBA_Q_CHUNK = 32

REL_BUCKETS = 32
REL_MAX_DISTANCE = 128

FFN_HIDDEN = ((8 * D_MODEL // 3 + 255) // 256) * 256
CONV_WIDTH = 3

kernel_name = "yoco_gla_moba_convffn_t5bias"


def rms_norm(x, w, eps=EPS):
    xf = x.astype(jnp.float32)
    y = xf * lax.rsqrt(jnp.mean(xf * xf, axis=-1, keepdims=True) + eps)
    return (y * w.astype(jnp.float32)).astype(x.dtype)


def rel_bucket(dist):
    max_exact = REL_BUCKETS // 2
    n = jnp.maximum(dist, 0)
    large = max_exact + (jnp.log(jnp.maximum(n, 1).astype(jnp.float32) / max_exact)
                         / math.log(REL_MAX_DISTANCE / max_exact)
                         * (REL_BUCKETS - max_exact)).astype(jnp.int32)
    large = jnp.minimum(large, REL_BUCKETS - 1)
    return jnp.where(n < max_exact, n, large)


def gla_mixer(x, norm_w, w_in, gk_w1, gk_w2, gk_b, o_norm_w, w_out):
    B, S, _ = x.shape
    H, dk, dv, C = GLA_HEADS, GLA_HEAD_K, GLA_HEAD_V, GLA_CHUNK
    nc = S // C
    f32 = jnp.float32
    xn = rms_norm(x, norm_w)
    proj = xn @ w_in
    q, k, v, g = jnp.split(proj, [GLA_KEY_DIM, 2 * GLA_KEY_DIM, 2 * GLA_KEY_DIM + GLA_VAL_DIM], axis=-1)
    gk = (xn @ gk_w1) @ gk_w2 + gk_b
    log_a = jax.nn.log_sigmoid(gk.astype(f32)) / GLA_GATE_NORMALIZER

    def to_chunks(t, d):
        return t.astype(f32).reshape(B, nc, C, H, d).transpose(0, 3, 1, 2, 4)

    q = to_chunks(q, dk) * (dk ** -0.5)
    k = to_chunks(k, dk)
    v = to_chunks(v, dv)
    b = jnp.cumsum(to_chunks(log_a, dk), axis=3)
    b_last = b[:, :, :, -1:, :]
    q_dec = q * jnp.exp(b)
    k_inv = k * jnp.exp(-b)
    k_end = k * jnp.exp(b_last - b)
    causal = jnp.tril(jnp.ones((C, C), dtype=bool))
    attn = jnp.where(causal, jnp.einsum('bhnqk,bhnsk->bhnqs', q_dec, k_inv), 0.0)
    o_intra = jnp.einsum('bhnqs,bhnsv->bhnqv', attn, v)
    chunk_decay = jnp.exp(b_last[:, :, :, 0, :])

    def step(state, inp):
        q_c, k_c, v_c, d_c = inp
        o_c = jnp.einsum('bhqk,bhkv->bhqv', q_c, state)
        state = state * d_c[..., None] + jnp.einsum('bhsk,bhsv->bhkv', k_c, v_c)
        return state, o_c

    xs = (jnp.moveaxis(q_dec, 2, 0), jnp.moveaxis(k_end, 2, 0),
          jnp.moveaxis(v, 2, 0), jnp.moveaxis(chunk_decay, 2, 0))
    _, o_inter = lax.scan(step, jnp.zeros((B, H, dk, dv), f32), xs)
    o = o_intra + jnp.moveaxis(o_inter, 0, 2)
    o = o.transpose(0, 2, 3, 1, 4).reshape(B, S, H, dv)
    o = rms_norm(o, o_norm_w) * jax.nn.silu(g.astype(f32)).reshape(B, S, H, dv)
    return o.reshape(B, S, GLA_VAL_DIM).astype(x.dtype) @ w_out


def conv_ffn(x, norm_w, w_up, conv_w, conv_b, w_down):
    S = x.shape[1]
    h = rms_norm(x, norm_w) @ w_up
    hp = jnp.pad(h, ((0, 0), (CONV_WIDTH - 1, 0), (0, 0)))
    acc = conv_b
    for j in range(CONV_WIDTH):
        acc = acc + conv_w[j] * hp[:, j:j + S]
    a, u = jnp.split(acc, 2, axis=-1)
    return (jax.nn.silu(a) * u) @ w_down


def shared_kv(x, norm_w, w_kv, k_norm_w):
    B, S, _ = x.shape
    H, Dh, BLK = MOBA_HEADS, MOBA_HEAD_DIM, MOBA_BLOCK
    nb = -(-S // BLK)
    s_pad = nb * BLK
    kv = rms_norm(x, norm_w) @ w_kv
    k, v = jnp.split(kv, 2, axis=-1)
    k = rms_norm(k.reshape(B, S, H, Dh), k_norm_w)
    v = v.reshape(B, S, H, Dh)
    pad = ((0, 0), (0, s_pad - S), (0, 0), (0, 0))
    k_blk = jnp.pad(k, pad).reshape(B, nb, BLK, H, Dh).transpose(0, 3, 1, 2, 4)
    v_blk = jnp.pad(v, pad).reshape(B, nb, BLK, H, Dh).transpose(0, 3, 1, 2, 4)
    k_mean = jnp.mean(k_blk.astype(jnp.float32), axis=3).astype(k_blk.dtype)
    return k_blk, v_blk, k_mean


def moba_mixer(x, norm_w, w_q, q_norm_w, w_out, k_blk, v_blk, k_mean, rel_bias):
    B, S, _ = x.shape
    H, Dh, BLK, QC = MOBA_HEADS, MOBA_HEAD_DIM, MOBA_BLOCK, MOBA_Q_CHUNK
    nb = k_blk.shape[2]
    topk = min(MOBA_TOPK, nb)
    q = (rms_norm(x, norm_w) @ w_q).reshape(B, S, H, Dh)
    q = (rms_norm(q, q_norm_w) * (Dh ** -0.5)).transpose(0, 2, 1, 3)
    bias_table = rel_bias.T
    b_idx = jnp.arange(B)[:, None, None, None]
    h_idx = jnp.arange(H)[None, :, None, None]
    blk_ids = jnp.arange(nb)
    offs = jnp.arange(BLK)

    def attend(c):
        start = c * QC
        q_c = lax.dynamic_slice_in_dim(q, start, QC, axis=2)
        t = start + jnp.arange(QC)
        own = start // BLK
        gate = jnp.einsum('bhqd,bhnd->bhqn', q_c, k_mean).astype(jnp.float32)
        gate = jnp.where(blk_ids < own, gate, -jnp.inf)
        _, sel = lax.top_k(gate, topk)
        sel_ok = jnp.arange(topk) < own
        k_sel = k_blk[b_idx, h_idx, sel]
        v_sel = v_blk[b_idx, h_idx, sel]
        pos_sel = sel[..., None] * BLK + offs
        s_sel = jnp.einsum('bhqd,bhqjkd->bhqjk', q_c, k_sel).astype(jnp.float32)
        s_sel = s_sel + bias_table[h_idx[..., None], rel_bucket(t[:, None, None] - pos_sel)]
        s_sel = jnp.where(sel_ok[:, None], s_sel, -jnp.inf)
        k_own = lax.dynamic_index_in_dim(k_blk, own, axis=2, keepdims=False)
        v_own = lax.dynamic_index_in_dim(v_blk, own, axis=2, keepdims=False)
        dist_own = t[:, None] - (own * BLK + offs)[None, :]
        s_own = jnp.einsum('bhqd,bhkd->bhqk', q_c, k_own).astype(jnp.float32)
        s_own = s_own + bias_table[:, rel_bucket(dist_own)][None]
        s_own = jnp.where(dist_own >= 0, s_own, -jnp.inf)
        scores = jnp.concatenate([s_sel.reshape(B, H, QC, topk * BLK), s_own], axis=-1)
        p = jax.nn.softmax(scores, axis=-1).astype(v_blk.dtype)
        p_sel = p[..., :topk * BLK].reshape(B, H, QC, topk, BLK)
        p_own = p[..., topk * BLK:]
        return (jnp.einsum('bhqjk,bhqjkd->bhqd', p_sel, v_sel)
                + jnp.einsum('bhqk,bhkd->bhqd', p_own, v_own))

    o = lax.map(attend, jnp.arange(S // QC))
    o = o.transpose(1, 0, 3, 2, 4).reshape(B, S, H * Dh)
    return o @ w_out


def setup_inputs(seed: int = 0) -> dict:
    key = jax.random.key(seed)
    ks = jax.random.split(key, 21)
    f32 = jnp.float32

    def nrm(k, shape, scale):
        return jax.random.normal(k, shape, f32) * scale

    def gain(k, shape):
        return 1.0 + 0.02 * jax.random.normal(k, shape, f32)

    D, KD, VD, R = D_MODEL, GLA_KEY_DIM, GLA_VAL_DIM, GLA_GATE_RANK
    HD = MOBA_HEADS * MOBA_HEAD_DIM
    F = FFN_HIDDEN
    return {
        "x": nrm(ks[0], (BATCH, SEQ, D), 1.0),
        "gla_norm": gain(ks[1], (N_A_LAYERS, D)),
        "gla_w_in": nrm(ks[2], (N_A_LAYERS, D, 2 * KD + 2 * VD), D ** -0.5),
        "gla_gk_w1": nrm(ks[3], (N_A_LAYERS, D, R), D ** -0.5),
        "gla_gk_w2": nrm(ks[4], (N_A_LAYERS, R, KD), R ** -0.5),
        "gla_gk_b": nrm(ks[5], (N_A_LAYERS, KD), 0.1),
        "gla_o_norm": gain(ks[6], (N_A_LAYERS, GLA_HEAD_V)),
        "gla_w_out": nrm(ks[7], (N_A_LAYERS, VD, D), VD ** -0.5),
        "kv_norm": gain(ks[8], (D,)),
        "kv_w": nrm(ks[9], (D, 2 * HD), D ** -0.5),
        "k_norm_w": gain(ks[10], (MOBA_HEAD_DIM,)),
        "moba_norm": gain(ks[11], (N_B_LAYERS, D)),
        "moba_w_q": nrm(ks[12], (N_B_LAYERS, D, HD), D ** -0.5),
        "moba_q_norm": gain(ks[13], (N_B_LAYERS, MOBA_HEAD_DIM)),
        "moba_w_out": nrm(ks[14], (N_B_LAYERS, HD, D), HD ** -0.5),
        "rel_bias": nrm(ks[15], (REL_BUCKETS, MOBA_HEADS), 0.2),
        "ffn_norm": gain(ks[16], (DEPTH, D)),
        "ffn_w_up": nrm(ks[17], (DEPTH, D, 2 * F), D ** -0.5),
        "ffn_conv_w": nrm(ks[18], (DEPTH, CONV_WIDTH, 2 * F), CONV_WIDTH ** -0.5),
        "ffn_conv_b": nrm(ks[19], (DEPTH, 2 * F), 0.02),
        "ffn_w_down": nrm(ks[20], (DEPTH, F, D), F ** -0.5),
    }


def reference(x, gla_norm, gla_w_in, gla_gk_w1, gla_gk_w2, gla_gk_b, gla_o_norm, gla_w_out,
              kv_norm, kv_w, k_norm_w, moba_norm, moba_w_q, moba_q_norm, moba_w_out, rel_bias,
              ffn_norm, ffn_w_up, ffn_conv_w, ffn_conv_b, ffn_w_down):
    h = x
    k_blk = v_blk = k_mean = None
    for layer in range(DEPTH):
        if layer < N_A_LAYERS:
            i = layer
            h = h + gla_mixer(h, gla_norm[i], gla_w_in[i], gla_gk_w1[i], gla_gk_w2[i],
                              gla_gk_b[i], gla_o_norm[i], gla_w_out[i])
        else:
            if layer == N_A_LAYERS:
                k_blk, v_blk, k_mean = shared_kv(h, kv_norm, kv_w, k_norm_w)
            j = layer - N_A_LAYERS
            h = h + moba_mixer(h, moba_norm[j], moba_w_q[j], moba_q_norm[j], moba_w_out[j],
                               k_blk, v_blk, k_mean, rel_bias)
        h = h + conv_ffn(h, ffn_norm[layer], ffn_w_up[layer], ffn_conv_w[layer],
                         ffn_conv_b[layer], ffn_w_down[layer])
    return h
```

```cpp
#include <hip/hip_runtime.h>
#include <hip/hip_cooperative_groups.h>
#include <cstdio>
namespace cg = cooperative_groups;
__device__ __forceinline__ int opaque_tid(int wv) { int t = __builtin_amdgcn_mbcnt_hi(~0u, __builtin_amdgcn_mbcnt_lo(~0u, 0u)); asm volatile("" : "+v"(t)); return wv * 64 + t; }
namespace pg8 {
#define PG8_LAS __attribute__((address_space(3)))
typedef unsigned short bf16_t;
typedef short bf16x8 __attribute__((ext_vector_type(8)));
typedef float f32x4 __attribute__((ext_vector_type(4)));
typedef unsigned u32x4 __attribute__((ext_vector_type(4)));
constexpr int BM = 256, BK = 64, HALF = 128, HTB = HALF * BK * 2  , STAGE_BYTES = 8 * HTB, NXCD = 8, WGM = 8;

__host__ __device__ __forceinline__ int lds_byte(int r, int c) { const int st = (r >> 4) * 2 + (c >> 5), rr = r & 15, cc = c & 31, ob = rr * 64 + cc * 2; return st * 1024 + (ob ^ (((ob >> 9) & 1) << 5)); }
__host__ __device__ __forceinline__ void stage_rc(int b, int& R, int& C) { const int st = b / 1024, sb = b % 1024, swz = sb ^ (((sb >> 9) & 1) << 5); R = (st >> 1) * 16 + swz / 64; C = (st & 1) * 32 + (swz % 64) / 2; }
__host__ __device__ __forceinline__ int perm32(int rho) { const int n = rho >> 4, i = rho & 15; return 8 * (i >> 2) + 4 * n + (i & 3); }

struct Unit { int pm, pn; };
struct Gemm { const bf16_t* A; const bf16_t* Bt; int M, N, K; };
struct StaticOrder {
    int nM, nN, nwg, G, c;
    __host__ __device__ void init(int M, int N, int G_, int c_) { nM = M / BM; nN = N / BM; nwg = nM * nN; G = G_; c = c_; }
    __host__ __device__ bool next(int i, Unit& u) const {
        const long L = (long)i * G + c; if (L >= nwg) return false;
        int wgid = (int)L; { const int q = nwg / NXCD, r = nwg % NXCD, xcd = wgid % NXCD, off = wgid / NXCD; wgid = (xcd < r ? xcd * (q + 1) : r * (q + 1) + (xcd - r) * q) + off; }
        const int nig = WGM * nN, gid = wgid / nig, fm = gid * WGM, gsz = (nM - fm) < WGM ? (nM - fm) : WGM;
        u.pm = fm + ((wgid % nig) % gsz); u.pn = (wgid % nig) / gsz; return true;
    }
    __device__ __forceinline__ void a_ready(const Unit&) const {}
    __device__ __forceinline__ void done(const Unit&) const {}
};
__device__ __forceinline__ unsigned cvt_pk_bf16(float lo, float hi) { unsigned r; asm volatile("v_cvt_pk_bf16_f32 %0, %1, %2" : "=v"(r) : "v"(lo), "v"(hi)); return r; }

template <class Epi, class Sched, bool STAMP = false>
__device__ __forceinline__ void gemm_phase(PG8_LAS unsigned char* lds, const Gemm g, const Sched& S, const Epi& E, unsigned long long* stamps, int wv) {
    const int tid = opaque_tid(wv), wid = __builtin_amdgcn_readfirstlane(tid >> 6), lane = tid & 63, wr = wid >> 2, wc = wid & 3, fr = lane & 15, fq = lane >> 4;
    const int K = g.K, nt = K / BK;
    int ts_lo = 0, ts_hi = 0, nts = 0; const unsigned long long rt_entry = STAMP ? (unsigned long long)wall_clock64() : 0ull;
#define PG8_STAMP() do { if (STAMP && wid == 0 && nts < 64) { const unsigned long long _c = (unsigned long long)clock64(); \
        ts_lo = (lane == nts) ? (int)(unsigned)_c : ts_lo; ts_hi = (lane == nts) ? (int)(unsigned)(_c >> 32) : ts_hi; ++nts; } } while (0)
    PG8_STAMP();
    unsigned voffA[2], voffB[2];
#pragma unroll
    for (int i = 0; i < 2; ++i) { int R, C; stage_rc(tid * 16 + i * 8192, R, C); const int Rb = Epi::PERM ? ((R & ~31) + perm32(R & 31)) : R;
        voffA[i] = (unsigned)(R * K + C) * 2u; voffB[i] = (unsigned)(Rb * K + C) * 2u; }
    const size_t kstep = (size_t)(BK * 2);
    const size_t hstep = (size_t)HALF * K * 2;
    const size_t tstep = 2 * hstep;
    const unsigned ldsw = (unsigned)wid * 1024u;
    const int aoff = lds_byte(wr * 64 + fr, fq * 8), boff = lds_byte(wc * 32 + fr, fq * 8);
#define PG8_SA(b, h) (((b) * 2 + (h)) * HTB)
#define PG8_SB(b, h) ((4 + (b) * 2 + (h)) * HTB)
#define PG8_STAGE(bufoff, gbase, voff) do { _Pragma("unroll") for (int _i = 0; _i < 2; ++_i) \
        __builtin_amdgcn_global_load_lds((const unsigned*)((const char*)(gbase) + (voff)[_i]), (PG8_LAS unsigned*)(lds + (bufoff) + ldsw + _i * 8192), 16, 0, 0); } while (0)
#define PG8_LDA(dst, b, h) do { _Pragma("unroll") for (int m = 0; m < 4; ++m) _Pragma("unroll") for (int k = 0; k < 2; ++k) dst[m][k] = *(const PG8_LAS bf16x8*)(lds + PG8_SA(b, h) + aoff + m * 2048 + k * 1024); } while (0)
#define PG8_LDB(dst, b, h) do { _Pragma("unroll") for (int n = 0; n < 2; ++n) _Pragma("unroll") for (int k = 0; k < 2; ++k) dst[n][k] = *(const PG8_LAS bf16x8*)(lds + PG8_SB(b, h) + boff + n * 2048 + k * 1024); } while (0)
#define PG8_MMA(ai, bj, At, Bt) do { __builtin_amdgcn_s_setprio(1); _Pragma("unroll") for (int m = 0; m < 4; ++m) _Pragma("unroll") for (int n = 0; n < 2; ++n) _Pragma("unroll") for (int k = 0; k < 2; ++k) \
        acc[ai][bj][m][n] = __builtin_amdgcn_mfma_f32_16x16x32_bf16(Bt[n][k], At[m][k], acc[ai][bj][m][n], 0, 0, 0); __builtin_amdgcn_s_setprio(0); } while (0)
#define PG8_WAIT_V(n) asm volatile("s_waitcnt vmcnt(" #n ")" ::: "memory")
#define PG8_WAIT_L(n) asm volatile("s_waitcnt lgkmcnt(" #n ")" ::: "memory")
#define PG8_BAR __builtin_amdgcn_s_barrier()
#define PG8_SCHED __builtin_amdgcn_sched_barrier(0)
    Unit cur, nxt; int ui = 0;
    if (!S.next(0, cur)) return;
    f32x4 acc[2][2][4][2];
#pragma unroll
    for (int a = 0; a < 2; ++a)
#pragma unroll
        for (int b = 0; b < 2; ++b)
#pragma unroll
            for (int m = 0; m < 4; ++m)
#pragma unroll
                for (int n = 0; n < 2; ++n) acc[a][b][m][n] = (f32x4){0.f, 0.f, 0.f, 0.f};
    bf16x8 At[4][2], B0[2][2], B1[2][2];
    const char* cA = (const char*)g.A + (size_t)cur.pm * tstep; const char* cB = (const char*)g.Bt + (size_t)cur.pn * tstep;
    S.a_ready(cur);
    PG8_STAGE(PG8_SB(0, 0), cB, voffB); PG8_STAGE(PG8_SA(0, 0), cA, voffA); PG8_STAGE(PG8_SB(0, 1), cB + hstep, voffB); PG8_STAGE(PG8_SA(0, 1), cA + hstep, voffA);
    if (wr == 1) PG8_BAR;
    PG8_WAIT_V(4); PG8_BAR;
    PG8_STAGE(PG8_SB(1, 0), cB + kstep, voffB); PG8_STAGE(PG8_SA(1, 0), cA + kstep, voffA); PG8_STAGE(PG8_SB(1, 1), cB + hstep + kstep, voffB);
    PG8_WAIT_V(6); PG8_BAR;
    PG8_STAMP();
    for (;;) {
        const bool has_next = S.next(ui + 1, nxt);
        const char* nA = has_next ? (const char*)g.A + (size_t)nxt.pm * tstep : cA; const char* nB = has_next ? (const char*)g.Bt + (size_t)nxt.pn * tstep : cB;
        for (int t = 0; t < nt; t += 2) {
            const bool last = (t == nt - 2);
            const char* a1 = cA + (size_t)(t + 1) * kstep;
            const char* a2 = last ? nA : cA + (size_t)(t + 2) * kstep; const char* b2 = last ? nB : cB + (size_t)(t + 2) * kstep;
            const char* a3 = a2 + kstep; const char* b3 = b2 + kstep;
            if (last && has_next) S.a_ready(nxt);
            PG8_LDB(B0, 0, 0); PG8_SCHED; PG8_LDA(At, 0, 0); PG8_STAGE(PG8_SA(1, 1), a1 + hstep, voffA);
            PG8_WAIT_L(8); PG8_BAR; PG8_WAIT_L(0); PG8_MMA(0, 0, At, B0); PG8_BAR; PG8_SCHED;
            PG8_LDB(B1, 0, 1); PG8_STAGE(PG8_SB(0, 0), b2, voffB);
            PG8_BAR; PG8_WAIT_L(0); PG8_MMA(0, 1, At, B1); PG8_BAR;
            PG8_LDA(At, 0, 1); PG8_STAGE(PG8_SA(0, 0), a2, voffA);
            PG8_BAR; PG8_WAIT_L(0); PG8_MMA(1, 0, At, B0); PG8_BAR; PG8_SCHED;
            PG8_STAGE(PG8_SB(0, 1), b2 + hstep, voffB);
            PG8_WAIT_V(6); PG8_BAR; PG8_MMA(1, 1, At, B1); PG8_BAR;
            PG8_LDB(B0, 1, 0); PG8_SCHED; PG8_LDA(At, 1, 0); PG8_STAGE(PG8_SA(0, 1), a2 + hstep, voffA);
            PG8_WAIT_L(8); PG8_BAR; PG8_WAIT_L(0); PG8_MMA(0, 0, At, B0); PG8_BAR; PG8_SCHED;
            PG8_LDB(B1, 1, 1); PG8_STAGE(PG8_SB(1, 0), b3, voffB);
            PG8_BAR; PG8_WAIT_L(0); PG8_MMA(0, 1, At, B1); PG8_BAR;
            PG8_LDA(At, 1, 1); PG8_STAGE(PG8_SA(1, 0), a3, voffA);
            PG8_BAR; PG8_WAIT_L(0); PG8_MMA(1, 0, At, B0); PG8_BAR; PG8_SCHED;
            PG8_STAGE(PG8_SB(1, 1), b3 + hstep, voffB);
            PG8_WAIT_V(6); PG8_BAR; PG8_MMA(1, 1, At, B1); PG8_BAR;
        }
        PG8_STAMP();
        if constexpr (!Epi::AFTER_DRAIN) { E(acc, cur, wr, wc, fr, fq); S.done(cur); }
        PG8_STAMP();
        if (!has_next) break;
#pragma unroll
        for (int a = 0; a < 2; ++a)
#pragma unroll
            for (int b = 0; b < 2; ++b)
#pragma unroll
                for (int m = 0; m < 4; ++m)
#pragma unroll
                    for (int n = 0; n < 2; ++n) acc[a][b][m][n] = (f32x4){0.f, 0.f, 0.f, 0.f};
        cur = nxt; cA = nA; cB = nB; ++ui;
    }
    PG8_WAIT_V(0);
    if (wr == 0) PG8_BAR;
    PG8_BAR;
    if constexpr (Epi::AFTER_DRAIN) { E.fused(acc, cur, wr, wc, fr, fq, lds, wid, lane); S.done(cur); }
    PG8_STAMP();
    if (STAMP && wid == 0) { stamps[lane] = lane < nts ? (((unsigned long long)(unsigned)ts_hi << 32) | (unsigned)ts_lo) : 0ull;
        if (lane == 62) stamps[62] = rt_entry; if (lane == 63) stamps[63] = (unsigned long long)wall_clock64(); }
#undef PG8_STAMP
#undef PG8_SA
#undef PG8_SB
#undef PG8_STAGE
#undef PG8_LDA
#undef PG8_LDB
#undef PG8_MMA
#undef PG8_WAIT_V
#undef PG8_WAIT_L
#undef PG8_BAR
#undef PG8_SCHED
}
}
using namespace pg8;
typedef unsigned int u32;

constexpr int S_ = 16384, D_ = 2048, NPROJ = 6144, F_ = 5632, F2_ = 11264, NH = 16, DH = 128;
constexpr size_t OFF_W = 0;
constexpr size_t OFF_BIG = 46137344;
constexpr size_t OFF_A3 = OFF_BIG + 369098752;
constexpr size_t OFF_SM = OFF_A3 + 184549376;
constexpr size_t OFF_GK1 = OFF_SM;
constexpr size_t OFF_DECAY = OFF_GK1 + 1048576;
constexpr size_t OFF_KMEAN = OFF_DECAY + 1048576;
constexpr size_t OFF_SEL = OFF_KMEAN + 524288;
constexpr size_t OFF_CNT = OFF_SEL + 1048576;
constexpr size_t OFF_CTR = OFF_CNT + 4096;
constexpr size_t OFF_ML = OFF_CTR + 256;
constexpr size_t WS_END = OFF_ML + 8388608;
constexpr size_t OFF_PROJ = OFF_BIG;
constexpr size_t OFF_QDEC = OFF_BIG + 201326592;
constexpr size_t OFF_KENDT = OFF_QDEC + 33554432;
constexpr size_t OFF_VT = OFF_KENDT + 33554432;
constexpr size_t OFF_A1 = OFF_QDEC;
constexpr size_t OFF_VTM = OFF_BIG + 268435456;
constexpr size_t OFF_LISTS = OFF_BIG + 335544320;
constexpr size_t OFF_OPART = OFF_BIG;
constexpr size_t OFF_KN = OFF_A3 + 67108864;
constexpr int LDS_BYTES = 163840;

struct Params { const float* in[21]; float* out; unsigned char* ws; };

__device__ __forceinline__ float bf2f(u32 b) { return __uint_as_float(b << 16); }
__device__ __forceinline__ float bflo(u32 w) { return __uint_as_float(w << 16); }
__device__ __forceinline__ float bfhi(u32 w) { return __uint_as_float(w & 0xffff0000u); }
__device__ __forceinline__ bf16_t f2bf(float f) { u32 u = __float_as_uint(f); u += 0x7FFFu + ((u >> 16) & 1u); return (bf16_t)(u >> 16); }
__device__ __forceinline__ u32 pk2(float lo, float hi) { return (u32)f2bf(lo) | ((u32)f2bf(hi) << 16); }
__device__ __forceinline__ float wave_sum(float v) {
#pragma unroll
    for (int o = 32; o; o >>= 1) v += __shfl_xor(v, o);
    return v;
}
__device__ __forceinline__ bf16x8 as_bf8(uint4 v) { return __builtin_bit_cast(bf16x8, v); }
__device__ __forceinline__ f32x4 mfma16(bf16x8 a, bf16x8 b, f32x4 c) { return __builtin_amdgcn_mfma_f32_16x16x32_bf16(a, b, c, 0, 0, 0); }

struct EpiBf16P {
    static constexpr bool PERM = true, AFTER_DRAIN = false;
    bf16_t* O; int ldc;
    __device__ __forceinline__ void operator()(const f32x4 (&acc)[2][2][4][2], const Unit& u, int wr, int wc, int fr, int fq) const {
        const int row0 = u.pm * BM + wr * 64 + fr; const int col0 = u.pn * BM + wc * 32 + 8 * fq;
#pragma unroll
        for (int ai = 0; ai < 2; ++ai)
#pragma unroll
            for (int m = 0; m < 4; ++m) { bf16_t* rowp = O + (size_t)(row0 + ai * HALF + m * 16) * ldc + col0;
#pragma unroll
                for (int bj = 0; bj < 2; ++bj) { const f32x4 v0 = acc[ai][bj][m][0], v1 = acc[ai][bj][m][1];
                    uint4 w; w.x = cvt_pk_bf16(v0[0], v0[1]); w.y = cvt_pk_bf16(v0[2], v0[3]); w.z = cvt_pk_bf16(v1[0], v1[1]); w.w = cvt_pk_bf16(v1[2], v1[3]);
                    *(uint4*)(rowp + bj * HALF) = w; } }
    }
};
struct EpiResF32 {
    static constexpr bool PERM = false, AFTER_DRAIN = false;
    const float* R; float* C; int ldc;
    __device__ __forceinline__ void operator()(const f32x4 (&acc)[2][2][4][2], const Unit& u, int wr, int wc, int fr, int fq) const {
        const int row0 = u.pm * BM + wr * 64 + fr, col0 = u.pn * BM + wc * 32 + 4 * fq;
#pragma unroll
        for (int ai = 0; ai < 2; ++ai)
#pragma unroll
            for (int m = 0; m < 4; ++m) { const size_t ro = (size_t)(row0 + ai * HALF + m * 16) * ldc + col0;
#pragma unroll
                for (int bj = 0; bj < 2; ++bj)
#pragma unroll
                    for (int n = 0; n < 2; ++n) { const f32x4 r = *(const f32x4*)(R + ro + bj * HALF + n * 16); *(f32x4*)(C + ro + bj * HALF + n * 16) = acc[ai][bj][m][n] + r; } }
    }
};

struct ConvJob { const float* W; const float* gain; bf16_t* dst; int K, N; };
__device__ __forceinline__ void conv_job(const ConvJob j, float* lds, int wv) {
    if (!j.W) return;
    const int tid = opaque_tid(wv);
    const int ntn = j.N >> 7, nt = ntn * (j.K >> 6);
    for (int tile = blockIdx.x; tile < nt; tile += gridDim.x) {
        const int k0 = (tile / ntn) << 6, n0 = (tile % ntn) << 7;
        float4 v[4];
#pragma unroll
        for (int i = 0; i < 4; ++i) { const int idx = tid + i * 512, kk = idx >> 5, n4 = idx & 31;
            v[i] = *(const float4*)(j.W + (size_t)(k0 + kk) * j.N + n0 + n4 * 4);
            const float g = j.gain ? j.gain[k0 + kk] : 1.0f; v[i].x *= g; v[i].y *= g; v[i].z *= g; v[i].w *= g; }
        __syncthreads();
#pragma unroll
        for (int i = 0; i < 4; ++i) { const int idx = tid + i * 512, kk = idx >> 5, n4 = idx & 31;
            lds[(n4 * 4 + 0) * 65 + kk] = v[i].x; lds[(n4 * 4 + 1) * 65 + kk] = v[i].y; lds[(n4 * 4 + 2) * 65 + kk] = v[i].z; lds[(n4 * 4 + 3) * 65 + kk] = v[i].w; }
        __syncthreads();
#pragma unroll
        for (int i = 0; i < 2; ++i) { const int idx = tid + i * 512, n = idx >> 3, kg = idx & 7; const float* s = lds + n * 65 + kg * 8;
            uint4 w; w.x = pk2(s[0], s[1]); w.y = pk2(s[2], s[3]); w.z = pk2(s[4], s[5]); w.w = pk2(s[6], s[7]);
            *(uint4*)(j.dst + (size_t)(n0 + n) * j.K + k0 + kg * 8) = w; }
    }
    __syncthreads();
}

template <bool GK>
__device__ __forceinline__ void norm_rows(const float* X, bf16_t* Y, const float* w1, const float* g, float* gk1, float* lds, int wv) {
    const int tid = opaque_tid(wv), lane = tid & 63, wid = tid >> 6;
    if (GK) { for (int e = tid; e < 32768; e += 512) { const int k = e >> 4, r = e & 15; lds[r * 2048 + k] = w1[e] * g[k]; } __syncthreads(); }
    const int nw = gridDim.x * 8;
    for (int t = blockIdx.x * 8 + wid; t < S_; t += nw) {
        float4 x[8]; float ss = 0.f;
#pragma unroll
        for (int i = 0; i < 8; ++i) { x[i] = *(const float4*)(X + (size_t)t * D_ + (i * 64 + lane) * 4); ss += x[i].x * x[i].x + x[i].y * x[i].y + x[i].z * x[i].z + x[i].w * x[i].w; }
        ss = wave_sum(ss);
        const float rinv = rsqrtf(ss * (1.0f / D_) + 1e-6f);
#pragma unroll
        for (int i = 0; i < 8; ++i) { uint2 w; w.x = pk2(x[i].x * rinv, x[i].y * rinv); w.y = pk2(x[i].z * rinv, x[i].w * rinv); *(uint2*)(Y + (size_t)t * D_ + (i * 64 + lane) * 4) = w; }
        if (GK) {
            float outv = 0.f;
#pragma unroll 2
            for (int r = 0; r < 16; ++r) { float a = 0.f;
#pragma unroll
                for (int i = 0; i < 8; ++i) { const float4 w = *(const float4*)(lds + r * 2048 + (i * 64 + lane) * 4); a += x[i].x * w.x + x[i].y * w.y + x[i].z * w.z + x[i].w * w.w; }
                a = wave_sum(a); if (lane == r) outv = a; }
            if (lane < 16) gk1[(size_t)t * 16 + lane] = outv * rinv;
        }
    }
    if (GK) __syncthreads();
}

__device__ __forceinline__ void gla_prep(const Params& p, unsigned char* smem, int wv) {
    const int tid = opaque_tid(wv), lane = tid & 63, wid = tid >> 6, fr = lane & 15, fq = lane >> 4;
    const bf16_t* proj = (const bf16_t*)(p.ws + OFF_PROJ);
    bf16_t* qdec = (bf16_t*)(p.ws + OFF_QDEC); bf16_t* kendT = (bf16_t*)(p.ws + OFF_KENDT); bf16_t* vTg = (bf16_t*)(p.ws + OFF_VT);
    float* O = (float*)(p.ws + OFF_A3); const float* gk1 = (const float*)(p.ws + OFF_GK1); float* decay = (float*)(p.ws + OFF_DECAY);
    const float* gk_w2 = p.in[4]; const float* gk_b = p.in[5];
    bf16_t* sVT = (bf16_t*)smem; bf16_t* sQ = (bf16_t*)(smem + 73728); bf16_t* sK = (bf16_t*)(smem + 107520); bf16_t* sAt = (bf16_t*)(smem + 141312);
    float* sTot = (float*)(smem + 150528); float* sG = (float*)(smem + 152576);
    for (int u = blockIdx.x; u < 1024; u += gridDim.x) {
        const int h = u & 3, n = u >> 2, t0 = n * 64;
        for (int e = tid; e < 1024; e += 512) sG[e] = gk1[(size_t)t0 * 16 + e];
#pragma unroll
        for (int it = 0; it < 8; ++it) { const int c8 = wid * 8 + it;
            const uint4 v = *(const uint4*)(proj + (size_t)(t0 + lane) * NPROJ + 2048 + h * 512 + c8 * 8);
            bf16_t* d = sVT + (c8 * 8) * 72 + lane;
            d[0] = (bf16_t)(v.x & 0xffff); d[72] = (bf16_t)(v.x >> 16); d[144] = (bf16_t)(v.y & 0xffff); d[216] = (bf16_t)(v.y >> 16);
            d[288] = (bf16_t)(v.z & 0xffff); d[360] = (bf16_t)(v.z >> 16); d[432] = (bf16_t)(v.w & 0xffff); d[504] = (bf16_t)(v.w >> 16); }
        __syncthreads();
        const int c = tid & 255, half = tid >> 8;
        float w2c[16];
#pragma unroll
        for (int r = 0; r < 16; ++r) w2c[r] = gk_w2[r * 1024 + h * 256 + c];
        const float bias = gk_b[h * 256 + c];
        { float run = 0.f;
#pragma unroll 2
          for (int i = 0; i < 32; ++i) { const float* gr = sG + (half * 32 + i) * 16; float gv = bias;
#pragma unroll
              for (int r = 0; r < 16; ++r) gv += gr[r] * w2c[r];
              run += (fminf(gv, 0.f) - log1pf(__expf(-fabsf(gv)))) * 0.0625f; }
          sTot[half * 256 + c] = run; }
        __syncthreads();
        const float blast = sTot[c] + sTot[256 + c];
        float brun = half ? sTot[c] : 0.f;
        if (half == 0) decay[(size_t)(h * 256 + n) * 256 + c] = __expf(blast);
        { bf16_t* kdst = kendT + ((size_t)(h * 256 + n) * 256 + c) * 64 + half * 32;
#pragma unroll 1
          for (int io = 0; io < 8; ++io) { u32 kp[2];
#pragma unroll
            for (int ii = 0; ii < 4; ++ii) { const int s = half * 32 + io * 4 + ii; const size_t t = (size_t)(t0 + s);
                const float* gr = sG + s * 16; float gv = bias;
#pragma unroll
                for (int r = 0; r < 16; ++r) gv += gr[r] * w2c[r];
                brun += (fminf(gv, 0.f) - log1pf(__expf(-fabsf(gv)))) * 0.0625f; const float b = brun;
                const float qv = bf2f(proj[t * NPROJ + h * 256 + c]), kv = bf2f(proj[t * NPROJ + 1024 + h * 256 + c]);
                const float qd = qv * 0.0625f * __expf(b), ki = kv * __expf(-b), ke = kv * __expf(blast - b);
                const bf16_t qb = f2bf(qd); sQ[s * 264 + c] = qb; sK[s * 264 + c] = f2bf(ki); qdec[t * 1024 + h * 256 + c] = qb;
                if (ii & 1) kp[ii >> 1] |= ((u32)f2bf(ke)) << 16; else kp[ii >> 1] = (u32)f2bf(ke); }
            *(uint2*)(kdst + io * 4) = make_uint2(kp[0], kp[1]); } }
        __syncthreads();
#pragma unroll
        for (int tt = 0; tt < 2; ++tt) { const int id = wid + tt * 8, st = id >> 2, qt = id & 3;
            f32x4 acc = {0.f, 0.f, 0.f, 0.f};
            if (st <= qt) {
#pragma unroll
                for (int ks = 0; ks < 8; ++ks) { const bf16x8 a = *(const bf16x8*)(sK + (st * 16 + fr) * 264 + ks * 32 + fq * 8); const bf16x8 b = *(const bf16x8*)(sQ + (qt * 16 + fr) * 264 + ks * 32 + fq * 8); acc = mfma16(a, b, acc); } }
            const int q = qt * 16 + fr, s0 = st * 16 + fq * 4;
            uint2 w; w.x = pk2(s0 <= q ? acc[0] : 0.f, s0 + 1 <= q ? acc[1] : 0.f); w.y = pk2(s0 + 2 <= q ? acc[2] : 0.f, s0 + 3 <= q ? acc[3] : 0.f);
            *(uint2*)(sAt + q * 72 + s0) = w; }
#pragma unroll
        for (int it = 0; it < 8; ++it) { const int idx = tid + it * 512, col = idx >> 3, part = idx & 7;
            *(uint4*)(vTg + ((size_t)(h * 256 + n) * 512 + col) * 64 + part * 8) = *(const uint4*)(sVT + col * 72 + part * 8); }
        __syncthreads();
        { bf16x8 bfr[4][2];
#pragma unroll
          for (int qt = 0; qt < 4; ++qt)
#pragma unroll
              for (int ks = 0; ks < 2; ++ks) bfr[qt][ks] = *(const bf16x8*)(sAt + (qt * 16 + fr) * 72 + ks * 32 + fq * 8);
#pragma unroll
          for (int vl = 0; vl < 4; ++vl) { const int vt = wid * 4 + vl;
              const bf16x8 a0 = *(const bf16x8*)(sVT + (vt * 16 + fr) * 72 + fq * 8), a1 = *(const bf16x8*)(sVT + (vt * 16 + fr) * 72 + 32 + fq * 8);
#pragma unroll
              for (int qt = 0; qt < 4; ++qt) { f32x4 acc = {0.f, 0.f, 0.f, 0.f}; acc = mfma16(a0, bfr[qt][0], acc); if (qt >= 2) acc = mfma16(a1, bfr[qt][1], acc);
                  *(f32x4*)(O + (size_t)(t0 + qt * 16 + fr) * 2048 + h * 512 + vt * 16 + fq * 4) = acc; } } }
        __syncthreads();
    }
}
__device__ __forceinline__ void gla_scan(const Params& p, unsigned char* smem, int wv) {
    const int tid = opaque_tid(wv), lane = tid & 63, wid = tid >> 6, fr = lane & 15, fq = lane >> 4;
    const bf16_t* qdec = (const bf16_t*)(p.ws + OFF_QDEC); const bf16_t* kendT = (const bf16_t*)(p.ws + OFF_KENDT); const bf16_t* vTg = (const bf16_t*)(p.ws + OFF_VT);
    float* O = (float*)(p.ws + OFF_A3); const float* decay = (const float*)(p.ws + OFF_DECAY);
    float* sRed = (float*)smem;
    for (int u0 = blockIdx.x; u0 < 256; u0 += gridDim.x) {
        const int xcd = u0 & 7, idx = u0 >> 3; if (idx >= 16) continue;
        const int h = xcd >> 1, v0 = ((xcd & 1) * 16 + idx) * 16, kw = wid * 32;
        const bf16_t* kb = kendT + ((size_t)h * 65536 + kw + fr) * 64 + fq * 8;
        const bf16_t* vb = vTg + ((size_t)h * 131072 + v0 + fr) * 64 + fq * 8;
        const bf16_t* qb = qdec + (size_t)fr * 1024 + h * 256 + kw + fq * 4;
        const float* db = decay + (size_t)h * 65536 + kw + fq * 4;
        const int e2 = tid * 2, oq = e2 >> 4, ov = e2 & 15;
        float* ob = O + (size_t)oq * 2048 + h * 512 + v0 + ov;
        uint4 kf[3][4], vf[3][2]; uint2 qf[3][8]; float4 df[3][2]; float2 of[3];
        f32x4 st[2] = {{0.f, 0.f, 0.f, 0.f}, {0.f, 0.f, 0.f, 0.f}};
#define SCAN_LOAD(s, n) do { \
            _Pragma("unroll") for (int mt = 0; mt < 2; ++mt) _Pragma("unroll") for (int ks = 0; ks < 2; ++ks) kf[s][mt * 2 + ks] = *(const uint4*)(kb + (size_t)(n) * 16384 + mt * 1024 + ks * 32); \
            _Pragma("unroll") for (int ks = 0; ks < 2; ++ks) vf[s][ks] = *(const uint4*)(vb + (size_t)(n) * 32768 + ks * 32); \
            _Pragma("unroll") for (int qt = 0; qt < 4; ++qt) { qf[s][qt * 2] = *(const uint2*)(qb + (size_t)((n) * 64 + qt * 16) * 1024); qf[s][qt * 2 + 1] = *(const uint2*)(qb + (size_t)((n) * 64 + qt * 16) * 1024 + 16); } \
            _Pragma("unroll") for (int mt = 0; mt < 2; ++mt) df[s][mt] = *(const float4*)(db + (size_t)(n) * 256 + mt * 16); \
            of[s] = *(const float2*)(ob + (size_t)(n) * 131072); } while (0)
        SCAN_LOAD(0, 0); SCAN_LOAD(1, 1);
        for (int n0 = 0; n0 < 256; n0 += 3) {
#pragma unroll
            for (int s = 0; s < 3; ++s) { const int n = n0 + s;
                if (n < 256) {
                    if (n + 2 < 256) { SCAN_LOAD((s + 2) % 3, n + 2); }
                    const int buf = n & 1;
                    uint4 sw; sw.x = cvt_pk_bf16(st[0][0], st[0][1]); sw.y = cvt_pk_bf16(st[0][2], st[0][3]); sw.z = cvt_pk_bf16(st[1][0], st[1][1]); sw.w = cvt_pk_bf16(st[1][2], st[1][3]);
                    const bf16x8 sb = as_bf8(sw);
                    float* red = sRed + buf * 8192 + wid * 1024;
#pragma unroll
                    for (int qt = 0; qt < 4; ++qt) { const uint4 aw = make_uint4(qf[s][qt * 2].x, qf[s][qt * 2].y, qf[s][qt * 2 + 1].x, qf[s][qt * 2 + 1].y);
                        f32x4 op = {0.f, 0.f, 0.f, 0.f}; op = mfma16(as_bf8(aw), sb, op);
#pragma unroll
                        for (int jj = 0; jj < 4; ++jj) red[(qt * 16 + fq * 4 + jj) * 16 + fr] = op[jj]; }
#pragma unroll
                    for (int mt = 0; mt < 2; ++mt) { f32x4 c; c[0] = st[mt][0] * df[s][mt].x; c[1] = st[mt][1] * df[s][mt].y; c[2] = st[mt][2] * df[s][mt].z; c[3] = st[mt][3] * df[s][mt].w;
                        c = mfma16(as_bf8(kf[s][mt * 2]), as_bf8(vf[s][0]), c); st[mt] = mfma16(as_bf8(kf[s][mt * 2 + 1]), as_bf8(vf[s][1]), c); }
                    __syncthreads();
                    float2 acc = of[s];
#pragma unroll
                    for (int w = 0; w < 8; ++w) { const float2 r = *(const float2*)(sRed + buf * 8192 + w * 1024 + e2); acc.x += r.x; acc.y += r.y; }
                    *(float2*)(ob + (size_t)n * 131072) = acc;
                } }
        }
#undef SCAN_LOAD
        __syncthreads();
    }
}

__device__ __forceinline__ void gla_onorm(const Params& p, int wv) {
    const int tid = opaque_tid(wv), lane = tid & 63, wid = tid >> 6;
    const float* O = (const float*)(p.ws + OFF_A3); const bf16_t* proj = (const bf16_t*)(p.ws + OFF_PROJ); bf16_t* A1 = (bf16_t*)(p.ws + OFF_A1);
    const float* onw = p.in[6];
    const float4 w0 = *(const float4*)(onw + lane * 8), w1 = *(const float4*)(onw + lane * 8 + 4);
    const int nw = gridDim.x * 8;
    for (int item = blockIdx.x * 8 + wid; item < S_ * 4; item += nw) { const size_t t = item >> 2; const int h = item & 3;
        const float4 a = *(const float4*)(O + t * 2048 + h * 512 + lane * 8), b = *(const float4*)(O + t * 2048 + h * 512 + lane * 8 + 4);
        const uint4 g = *(const uint4*)(proj + t * NPROJ + 4096 + h * 512 + lane * 8);
        float ss = a.x * a.x + a.y * a.y + a.z * a.z + a.w * a.w + b.x * b.x + b.y * b.y + b.z * b.z + b.w * b.w;
        ss = wave_sum(ss); const float r = rsqrtf(ss * (1.0f / 512.0f) + 1e-6f);
        float o[8] = {a.x * r * w0.x, a.y * r * w0.y, a.z * r * w0.z, a.w * r * w0.w, b.x * r * w1.x, b.y * r * w1.y, b.z * r * w1.z, b.w * r * w1.w};
        const float gv[8] = {bflo(g.x), bfhi(g.x), bflo(g.y), bfhi(g.y), bflo(g.z), bfhi(g.z), bflo(g.w), bfhi(g.w)};
#pragma unroll
        for (int i = 0; i < 8; ++i) o[i] *= gv[i] / (1.0f + __expf(-gv[i]));
        uint4 w; w.x = pk2(o[0], o[1]); w.y = pk2(o[2], o[3]); w.z = pk2(o[4], o[5]); w.w = pk2(o[6], o[7]);
        *(uint4*)(A1 + t * 2048 + h * 512 + lane * 8) = w; }
}

__device__ __forceinline__ void ffn_act(const Params& p, int layer, int wv) {
    const bf16_t* hU = (const bf16_t*)(p.ws + OFF_BIG); bf16_t* act = (bf16_t*)(p.ws + OFF_A3);
    const float* cw = p.in[18] + (size_t)layer * 3 * F2_; const float* cb = p.in[19] + (size_t)layer * F2_;
    const int gsz = gridDim.x * 512;
    for (int item = blockIdx.x * 512 + opaque_tid(wv); item < 704 * 1024; item += gsz) { const int cgp = item % 704, rr = item / 704, f0 = cgp * 8, t0 = rr * 16;
        float wa[3][8], wu[3][8], ba[8], bu[8];
#pragma unroll
        for (int j = 0; j < 3; ++j)
#pragma unroll
            for (int e = 0; e < 8; e += 4) { const float4 x = *(const float4*)(cw + j * F2_ + f0 + e), y = *(const float4*)(cw + j * F2_ + F_ + f0 + e);
                wa[j][e] = x.x; wa[j][e + 1] = x.y; wa[j][e + 2] = x.z; wa[j][e + 3] = x.w; wu[j][e] = y.x; wu[j][e + 1] = y.y; wu[j][e + 2] = y.z; wu[j][e + 3] = y.w; }
#pragma unroll
        for (int e = 0; e < 8; e += 4) { const float4 x = *(const float4*)(cb + f0 + e), y = *(const float4*)(cb + F_ + f0 + e);
            ba[e] = x.x; ba[e + 1] = x.y; ba[e + 2] = x.z; ba[e + 3] = x.w; bu[e] = y.x; bu[e + 1] = y.y; bu[e + 2] = y.z; bu[e + 3] = y.w; }
        uint4 a2 = make_uint4(0, 0, 0, 0), a1 = a2, u2 = a2, u1 = a2;
        if (t0 > 0) { a2 = *(const uint4*)(hU + (size_t)(t0 - 2) * F2_ + f0); a1 = *(const uint4*)(hU + (size_t)(t0 - 1) * F2_ + f0);
                      u2 = *(const uint4*)(hU + (size_t)(t0 - 2) * F2_ + F_ + f0); u1 = *(const uint4*)(hU + (size_t)(t0 - 1) * F2_ + F_ + f0); }
#pragma unroll 4
        for (int i = 0; i < 16; ++i) { const size_t t = (size_t)(t0 + i);
            const uint4 a0 = *(const uint4*)(hU + t * F2_ + f0), u0 = *(const uint4*)(hU + t * F2_ + F_ + f0);
            const u32 A2[4] = {a2.x, a2.y, a2.z, a2.w}, A1[4] = {a1.x, a1.y, a1.z, a1.w}, A0[4] = {a0.x, a0.y, a0.z, a0.w};
            const u32 U2[4] = {u2.x, u2.y, u2.z, u2.w}, U1[4] = {u1.x, u1.y, u1.z, u1.w}, U0[4] = {u0.x, u0.y, u0.z, u0.w};
            u32 ow[4];
#pragma unroll
            for (int e = 0; e < 4; ++e) {
                const float al = ba[2 * e] + wa[0][2 * e] * bflo(A2[e]) + wa[1][2 * e] * bflo(A1[e]) + wa[2][2 * e] * bflo(A0[e]);
                const float ah = ba[2 * e + 1] + wa[0][2 * e + 1] * bfhi(A2[e]) + wa[1][2 * e + 1] * bfhi(A1[e]) + wa[2][2 * e + 1] * bfhi(A0[e]);
                const float ul = bu[2 * e] + wu[0][2 * e] * bflo(U2[e]) + wu[1][2 * e] * bflo(U1[e]) + wu[2][2 * e] * bflo(U0[e]);
                const float uh = bu[2 * e + 1] + wu[0][2 * e + 1] * bfhi(U2[e]) + wu[1][2 * e + 1] * bfhi(U1[e]) + wu[2][2 * e + 1] * bfhi(U0[e]);
                ow[e] = pk2(al / (1.0f + __expf(-al)) * ul, ah / (1.0f + __expf(-ah)) * uh); }
            *(uint4*)(act + t * F_ + f0) = make_uint4(ow[0], ow[1], ow[2], ow[3]);
            a2 = a1; a1 = a0; u2 = u1; u1 = u0; }
    }
}

__device__ __forceinline__ void moba_prep(const Params& p, unsigned char* smem, int wv) {
    const int tid = opaque_tid(wv), lane = tid & 63, wid = tid >> 6, l16 = lane & 15, sub = lane >> 4;
    const bf16_t* raw = (const bf16_t*)(p.ws + OFF_PROJ); bf16_t* qn = (bf16_t*)(p.ws + OFF_A3); bf16_t* kn = (bf16_t*)(p.ws + OFF_KN); bf16_t* vTm = (bf16_t*)(p.ws + OFF_VTM);
    float* kmean = (float*)(p.ws + OFF_KMEAN);
    bf16_t* sV = (bf16_t*)smem; float* sKm = (float*)(smem + 67584);
    { int* cnt = (int*)(p.ws + OFF_CNT); int* ctr = (int*)(p.ws + OFF_CTR);
      for (int e = blockIdx.x * 512 + tid; e < 1024; e += gridDim.x * 512) cnt[e] = 256;
      if (blockIdx.x == 0 && tid == 0) ctr[0] = 0; }
    float qw[8], kwt[8];
#pragma unroll
    for (int e = 0; e < 8; ++e) { qw[e] = p.in[13][l16 * 8 + e] * 0.08838834764831845f; kwt[e] = p.in[10][l16 * 8 + e]; }
    for (int u = blockIdx.x; u < 1024; u += gridDim.x) { const int h = u & 15, j = u >> 4;
#pragma unroll
        for (int it = 0; it < 8; ++it) { const int key = lane + 64 * (wid & 3), dg = it * 2 + (wid >> 2);
            const uint4 v = *(const uint4*)(raw + (size_t)(j * 256 + key) * NPROJ + 4096 + h * 128 + dg * 8);
            bf16_t* d = sV + (dg * 8) * 264 + key;
            d[0] = (bf16_t)(v.x & 0xffff); d[264] = (bf16_t)(v.x >> 16); d[528] = (bf16_t)(v.y & 0xffff); d[792] = (bf16_t)(v.y >> 16);
            d[1056] = (bf16_t)(v.z & 0xffff); d[1320] = (bf16_t)(v.z >> 16); d[1584] = (bf16_t)(v.w & 0xffff); d[1848] = (bf16_t)(v.w >> 16); }
        float ksum[8] = {0.f, 0.f, 0.f, 0.f, 0.f, 0.f, 0.f, 0.f};
#pragma unroll 2
        for (int it = 0; it < 8; ++it) { const size_t t = (size_t)(j * 256 + wid * 32 + it * 4 + sub);
            const uint4 qv = *(const uint4*)(raw + t * NPROJ + h * 128 + l16 * 8), kv = *(const uint4*)(raw + t * NPROJ + 2048 + h * 128 + l16 * 8);
            float q[8] = {bflo(qv.x), bfhi(qv.x), bflo(qv.y), bfhi(qv.y), bflo(qv.z), bfhi(qv.z), bflo(qv.w), bfhi(qv.w)};
            float k[8] = {bflo(kv.x), bfhi(kv.x), bflo(kv.y), bfhi(kv.y), bflo(kv.z), bfhi(kv.z), bflo(kv.w), bfhi(kv.w)};
            float sq = 0.f, sk = 0.f;
#pragma unroll
            for (int e = 0; e < 8; ++e) { sq += q[e] * q[e]; sk += k[e] * k[e]; }
#pragma unroll
            for (int o = 1; o < 16; o <<= 1) { sq += __shfl_xor(sq, o); sk += __shfl_xor(sk, o); }
            const float rq = rsqrtf(sq * (1.0f / 128.0f) + 1e-6f), rk = rsqrtf(sk * (1.0f / 128.0f) + 1e-6f);
#pragma unroll
            for (int e = 0; e < 8; ++e) { q[e] *= rq * qw[e]; k[e] *= rk * kwt[e]; ksum[e] += k[e]; }
            *(uint4*)(qn + ((size_t)h * S_ + t) * 128 + l16 * 8) = make_uint4(pk2(q[0], q[1]), pk2(q[2], q[3]), pk2(q[4], q[5]), pk2(q[6], q[7]));
            *(uint4*)(kn + ((size_t)h * S_ + t) * 128 + l16 * 8) = make_uint4(pk2(k[0], k[1]), pk2(k[2], k[3]), pk2(k[4], k[5]), pk2(k[6], k[7])); }
#pragma unroll
        for (int e = 0; e < 8; ++e) { ksum[e] += __shfl_xor(ksum[e], 16); ksum[e] += __shfl_xor(ksum[e], 32); }
        if (sub == 0) {
#pragma unroll
            for (int e = 0; e < 8; ++e) sKm[wid * 128 + l16 * 8 + e] = ksum[e]; }
        __syncthreads();
        if (tid < 128) { float s = 0.f;
#pragma unroll
            for (int w = 0; w < 8; ++w) s += sKm[w * 128 + tid];
            kmean[(size_t)(h * 64 + j) * 128 + tid] = s * (1.0f / 256.0f); }
#pragma unroll
        for (int it = 0; it < 8; ++it) { const int id = it * 512 + tid, d = id >> 5, part = id & 31;
            *(uint4*)(vTm + ((size_t)(h * 64 + j) * 128 + d) * 256 + part * 8) = *(const uint4*)(sV + d * 264 + part * 8); }
        __syncthreads();
    }
}

__device__ __forceinline__ void moba_gate(const Params& p, unsigned char* smem, int wv) {
    const int tid = opaque_tid(wv);
    const bf16_t* qn = (const bf16_t*)(p.ws + OFF_A3); const float* kmean = (const float*)(p.ws + OFF_KMEAN);
    int* cnt = (int*)(p.ws + OFF_CNT); bf16_t* lists = (bf16_t*)(p.ws + OFF_LISTS);
    float* sKm = (float*)smem;
    for (int u = blockIdx.x; u < 1024; u += gridDim.x) { const int h = u & 15, b = u >> 4;
        for (int e = tid; e < b * 128; e += 512) sKm[e] = kmean[(size_t)h * 8192 + e];
        __syncthreads();
        const int qi = tid >> 1, par = tid & 1, t = b * 256 + qi;
        uint4 q[16];
#pragma unroll
        for (int i = 0; i < 16; ++i) q[i] = *(const uint4*)(qn + ((size_t)h * S_ + t) * 128 + i * 8);
        float v0 = -INFINITY, v1 = -INFINITY, v2 = -INFINITY; int i0 = 255, i1 = 255, i2 = 255;
#define TOP_INS(g, n) do { if ((g) > v0) { v2 = v1; i2 = i1; v1 = v0; i1 = i0; v0 = (g); i0 = (n); } else if ((g) > v1) { v2 = v1; i2 = i1; v1 = (g); i1 = (n); } else if ((g) > v2) { v2 = (g); i2 = (n); } } while (0)
        for (int n = par; n < b; n += 2) { const float4* km = (const float4*)(sKm + n * 128); float g = 0.f;
#pragma unroll
            for (int i = 0; i < 16; ++i) { const float4 k0 = km[2 * i], k1 = km[2 * i + 1];
                g += bflo(q[i].x) * k0.x + bfhi(q[i].x) * k0.y + bflo(q[i].y) * k0.z + bfhi(q[i].y) * k0.w + bflo(q[i].z) * k1.x + bfhi(q[i].z) * k1.y + bflo(q[i].w) * k1.z + bfhi(q[i].w) * k1.w; }
            TOP_INS(g, n); }
        { const float pv0 = __shfl_xor(v0, 1), pv1 = __shfl_xor(v1, 1), pv2 = __shfl_xor(v2, 1); const int pi0 = __shfl_xor(i0, 1), pi1 = __shfl_xor(i1, 1), pi2 = __shfl_xor(i2, 1);
          TOP_INS(pv0, pi0); TOP_INS(pv1, pi1); TOP_INS(pv2, pi2); }
#undef TOP_INS
        if (par == 0) {
            lists[(size_t)(h * 64 + b) * 16384 + qi] = (bf16_t)((t << 2) | 3);
            if (i0 != 255) { const int pos = atomicAdd(&cnt[h * 64 + i0], 1); lists[(size_t)(h * 64 + i0) * 16384 + pos] = (bf16_t)((t << 2) | 0); }
            if (i1 != 255) { const int pos = atomicAdd(&cnt[h * 64 + i1], 1); lists[(size_t)(h * 64 + i1) * 16384 + pos] = (bf16_t)((t << 2) | 1); }
            if (i2 != 255) { const int pos = atomicAdd(&cnt[h * 64 + i2], 1); lists[(size_t)(h * 64 + i2) * 16384 + pos] = (bf16_t)((t << 2) | 2); }
        }
        __syncthreads();
    }
}
__device__ __forceinline__ void moba_attn(const Params& p, unsigned char* smem, int wv) {
    const int tid = opaque_tid(wv), lane = tid & 63, wid = tid >> 6, fr = lane & 15, fq = lane >> 4;
    const bf16_t* qn = (const bf16_t*)(p.ws + OFF_A3); const bf16_t* kn = (const bf16_t*)(p.ws + OFF_KN); const bf16_t* vTm = (const bf16_t*)(p.ws + OFF_VTM);
    const int* cntg = (const int*)(p.ws + OFF_CNT); int* ctr = (int*)(p.ws + OFF_CTR); const bf16_t* lists = (const bf16_t*)(p.ws + OFF_LISTS);
    bf16_t* opart = (bf16_t*)(p.ws + OFF_OPART); float2* ml = (float2*)(p.ws + OFF_ML);
    const float* rel_bias = p.in[15];
    bf16_t* sKs = (bf16_t*)smem; bf16_t* sVT = (bf16_t*)(smem + 69632); float* sBias = (float*)(smem + 137216); int* sU = (int*)(smem + 138240);
    for (;;) {
        if (tid == 0) *sU = atomicAdd(ctr, 1);
        __syncthreads();
        const int u = *sU;
        if (u >= 1024) break;
        const int j = u >> 4, h = u & 15;
#pragma unroll
        for (int it = 0; it < 8; ++it) { const int id = it * 512 + tid;
            { const int key = id >> 4, dg = id & 15; *(uint4*)(sKs + key * 136 + dg * 8) = *(const uint4*)(kn + ((size_t)h * S_ + j * 256 + key) * 128 + dg * 8); }
            { const int d = id >> 5, part = id & 31; *(uint4*)(sVT + d * 264 + part * 8) = *(const uint4*)(vTm + ((size_t)(h * 64 + j) * 128 + d) * 256 + part * 8); } }
        if (tid < 129) { int bk = tid; if (tid >= 16) { bk = 16 + (int)(__logf((float)tid * 0.0625f) / 2.0794415416798357f * 16.0f); bk = bk > 31 ? 31 : bk; } sBias[tid] = rel_bias[bk * 16 + h]; }
        __syncthreads();
        const int cnt = cntg[h * 64 + j], npass = (cnt + 255) >> 8;
        const bf16_t* L = lists + (size_t)(h * 64 + j) * 16384;
        for (int pass = 0; pass < npass; ++pass) {
            const int base = pass * 256 + wid * 32;
            if (base >= cnt) continue;
            int tq[2], rq[2]; bool valid[2]; uint4 qf[2][4];
#pragma unroll
            for (int qt = 0; qt < 2; ++qt) { const int li = base + qt * 16 + fr; valid[qt] = li < cnt; const u32 e = L[valid[qt] ? li : base]; tq[qt] = (int)(e >> 2); rq[qt] = (int)(e & 3);
#pragma unroll
                for (int ks = 0; ks < 4; ++ks) qf[qt][ks] = *(const uint4*)(qn + ((size_t)h * S_ + tq[qt]) * 128 + ks * 32 + fq * 8); }
            float m[2] = {-1e30f, -1e30f}, l[2] = {0.f, 0.f};
            f32x4 oT[8][2];
#pragma unroll
            for (int dt = 0; dt < 8; ++dt) { oT[dt][0] = (f32x4){0.f, 0.f, 0.f, 0.f}; oT[dt][1] = (f32x4){0.f, 0.f, 0.f, 0.f}; }
            for (int kc = 0; kc < 4; ++kc) {
                if (pass == 0 && kc * 64 > wid * 32 + 31) continue;
                f32x4 sT[4][2];
#pragma unroll
                for (int kt = 0; kt < 4; ++kt) { sT[kt][0] = (f32x4){0.f, 0.f, 0.f, 0.f}; sT[kt][1] = (f32x4){0.f, 0.f, 0.f, 0.f};
#pragma unroll
                    for (int ks = 0; ks < 4; ++ks) { const bf16x8 a = *(const bf16x8*)(sKs + (kc * 64 + kt * 16 + fr) * 136 + ks * 32 + fq * 8);
                        sT[kt][0] = mfma16(a, as_bf8(qf[0][ks]), sT[kt][0]); sT[kt][1] = mfma16(a, as_bf8(qf[1][ks]), sT[kt][1]); } }
                uint4 pb[2][2];
#pragma unroll
                for (int qt = 0; qt < 2; ++qt) { float cm = -1e30f;
#pragma unroll
                    for (int kt = 0; kt < 4; ++kt)
#pragma unroll
                        for (int jj = 0; jj < 4; ++jj) { const int dd = tq[qt] - (j * 256 + kc * 64 + kt * 16 + fq * 4 + jj);
                            const float s = dd >= 0 ? sT[kt][qt][jj] + sBias[dd > 128 ? 128 : dd] : -1e30f; sT[kt][qt][jj] = s; cm = fmaxf(cm, s); }
                    cm = fmaxf(cm, __shfl_xor(cm, 16)); cm = fmaxf(cm, __shfl_xor(cm, 32));
                    const float mn = fmaxf(m[qt], cm), alpha = __expf(m[qt] - mn); m[qt] = mn; float ls = l[qt] * alpha;
#pragma unroll
                    for (int dt = 0; dt < 8; ++dt) { oT[dt][qt][0] *= alpha; oT[dt][qt][1] *= alpha; oT[dt][qt][2] *= alpha; oT[dt][qt][3] *= alpha; }
                    float pv[4][4];
#pragma unroll
                    for (int kt = 0; kt < 4; ++kt)
#pragma unroll
                        for (int jj = 0; jj < 4; ++jj) { pv[kt][jj] = __expf(sT[kt][qt][jj] - mn); ls += pv[kt][jj]; }
                    l[qt] = ls;
#pragma unroll
                    for (int kk = 0; kk < 2; ++kk) pb[qt][kk] = make_uint4(cvt_pk_bf16(pv[2 * kk][0], pv[2 * kk][1]), cvt_pk_bf16(pv[2 * kk][2], pv[2 * kk][3]), cvt_pk_bf16(pv[2 * kk + 1][0], pv[2 * kk + 1][1]), cvt_pk_bf16(pv[2 * kk + 1][2], pv[2 * kk + 1][3])); }
#pragma unroll
                for (int kk = 0; kk < 2; ++kk)
#pragma unroll
                    for (int dt = 0; dt < 8; ++dt) { const bf16_t* vp = sVT + (dt * 16 + fr) * 264 + kc * 64 + kk * 32 + fq * 4;
                        const uint2 lo = *(const uint2*)vp, hi = *(const uint2*)(vp + 16); const bf16x8 a = as_bf8(make_uint4(lo.x, lo.y, hi.x, hi.y));
                        oT[dt][0] = mfma16(a, as_bf8(pb[0][kk]), oT[dt][0]); oT[dt][1] = mfma16(a, as_bf8(pb[1][kk]), oT[dt][1]); }
            }
#pragma unroll
            for (int qt = 0; qt < 2; ++qt) { float lt = l[qt]; lt += __shfl_xor(lt, 16); lt += __shfl_xor(lt, 32); const float inv = 1.0f / lt;
                if (valid[qt]) { const size_t slot = ((size_t)tq[qt] * 16 + h) * 4 + rq[qt];
#pragma unroll
                    for (int dt = 0; dt < 8; ++dt) *(uint2*)(opart + slot * 128 + dt * 16 + fq * 4) = make_uint2(pk2(oT[dt][qt][0] * inv, oT[dt][qt][1] * inv), pk2(oT[dt][qt][2] * inv, oT[dt][qt][3] * inv));
                    if (fq == 0) ml[slot] = make_float2(m[qt], lt); } }
        }
        __syncthreads();
    }
}

__device__ __forceinline__ void moba_combine(const Params& p, int wv) {
    const int tid = opaque_tid(wv), lane = tid & 63, wid = tid >> 6;
    const bf16_t* opart = (const bf16_t*)(p.ws + OFF_OPART); const float2* ml = (const float2*)(p.ws + OFF_ML); bf16_t* A5 = (bf16_t*)(p.ws + OFF_A3);
    const int nw = gridDim.x * 8;
    for (int item = blockIdx.x * 8 + wid; item < S_ * 16; item += nw) { const int t = item >> 4, h = item & 15, own = t >> 8, nsel = own < 3 ? own : 3;
        const size_t slot0 = (size_t)item * 4;
        float mr[4], lr[4]; float M = -1e30f;
#pragma unroll
        for (int r = 0; r < 4; ++r) { const bool ok = (r == 3) || (r < nsel); mr[r] = -1e30f; lr[r] = 0.f; if (ok) { const float2 v = ml[slot0 + r]; mr[r] = v.x; lr[r] = v.y; } M = fmaxf(M, mr[r]); }
        float W = 0.f, o0 = 0.f, o1 = 0.f;
#pragma unroll
        for (int r = 0; r < 4; ++r) { const bool ok = (r == 3) || (r < nsel);
            if (ok) { const float w = __expf(mr[r] - M) * lr[r]; W += w; const u32 x = *(const u32*)(opart + (slot0 + r) * 128 + lane * 2); o0 += w * bflo(x); o1 += w * bfhi(x); } }
        const float inv = 1.0f / W;
        *(u32*)(A5 + (size_t)t * 2048 + h * 128 + lane * 2) = pk2(o0 * inv, o1 * inv); }
}

enum { K_NORM_GK = 0, K_NORM, K_GEMM_BF16, K_GEMM_RES, K_GLA_PREP, K_GLA_SCAN, K_ONORM, K_ACT, K_MOBA_PREP, K_GATE, K_ATTN, K_COMBINE };
constexpr int NSTEP = 21;

__global__ void __launch_bounds__(512, 2) fwd_kernel(Params p) {
    extern __shared__ __attribute__((aligned(16))) unsigned char smem[];
    cg::grid_group grid = cg::this_grid();
    const int wv = __builtin_amdgcn_readfirstlane((int)(threadIdx.x >> 6));
    bf16_t* W = (bf16_t*)(p.ws + OFF_W);
    float* out = p.out;
    for (int step = 0; step < NSTEP; ++step) {
        int kind = 0, layer = 0; ConvJob c0 = {nullptr, nullptr, nullptr, 0, 0}, c1 = c0;
        Gemm g = {nullptr, nullptr, S_, 0, 0}; bf16_t* gO = nullptr; const float* gR = nullptr;
        switch (step) {
        case 0: kind = K_NORM_GK; c0 = {p.in[2], p.in[1], W, D_, NPROJ}; break;
        case 1: kind = K_GEMM_BF16; g = {(const bf16_t*)(p.ws + OFF_A3), W, S_, NPROJ, D_}; gO = (bf16_t*)(p.ws + OFF_PROJ); break;
        case 2: kind = K_GLA_PREP; c0 = {p.in[7], nullptr, W, D_, D_}; break;
        case 3: kind = K_GLA_SCAN; break;
        case 4: kind = K_ONORM; break;
        case 5: kind = K_GEMM_RES; g = {(const bf16_t*)(p.ws + OFF_A1), W, S_, D_, D_}; gR = p.in[0]; break;
        case 6: kind = K_NORM; c0 = {p.in[17], p.in[16], W, D_, F2_}; break;
        case 7: kind = K_GEMM_BF16; g = {(const bf16_t*)(p.ws + OFF_A3), W, S_, F2_, D_}; gO = (bf16_t*)(p.ws + OFF_BIG); break;
        case 8: kind = K_ACT; layer = 0; c0 = {p.in[20], nullptr, W, F_, D_}; break;
        case 9: kind = K_GEMM_RES; g = {(const bf16_t*)(p.ws + OFF_A3), W, S_, D_, F_}; gR = out; break;
        case 10: kind = K_NORM; c0 = {p.in[12], p.in[11], W, D_, D_}; c1 = {p.in[9], p.in[8], W + (size_t)D_ * D_, D_, 2 * D_}; break;
        case 11: kind = K_GEMM_BF16; g = {(const bf16_t*)(p.ws + OFF_A3), W, S_, NPROJ, D_}; gO = (bf16_t*)(p.ws + OFF_PROJ); break;
        case 12: kind = K_MOBA_PREP; break;
        case 13: kind = K_GATE; break;
        case 14: kind = K_ATTN; break;
        case 15: kind = K_COMBINE; c0 = {p.in[14], nullptr, W, D_, D_}; break;
        case 16: kind = K_GEMM_RES; g = {(const bf16_t*)(p.ws + OFF_A3), W, S_, D_, D_}; gR = out; break;
        case 17: kind = K_NORM; c0 = {p.in[17] + (size_t)D_ * F2_, p.in[16] + D_, W, D_, F2_}; break;
        case 18: kind = K_GEMM_BF16; g = {(const bf16_t*)(p.ws + OFF_A3), W, S_, F2_, D_}; gO = (bf16_t*)(p.ws + OFF_BIG); break;
        case 19: kind = K_ACT; layer = 1; c0 = {p.in[20] + (size_t)F_ * D_, nullptr, W, F_, D_}; break;
        default: kind = K_GEMM_RES; g = {(const bf16_t*)(p.ws + OFF_A3), W, S_, D_, F_}; gR = out; break;
        }
        conv_job(c0, (float*)smem, wv);
        conv_job(c1, (float*)smem, wv);
        switch (kind) {
        case K_NORM_GK: norm_rows<true>(p.in[0], (bf16_t*)(p.ws + OFF_A3), p.in[3], p.in[1], (float*)(p.ws + OFF_GK1), (float*)smem, wv); break;
        case K_NORM: norm_rows<false>(out, (bf16_t*)(p.ws + OFF_A3), nullptr, nullptr, nullptr, (float*)smem, wv); break;
        case K_GEMM_BF16: { StaticOrder so; so.init(g.M, g.N, (int)gridDim.x, (int)blockIdx.x); EpiBf16P e{gO, g.N}; gemm_phase<EpiBf16P, StaticOrder, false>((PG8_LAS unsigned char*)smem, g, so, e, nullptr, wv); } break;
        case K_GEMM_RES: { StaticOrder so; so.init(g.M, g.N, (int)gridDim.x, (int)blockIdx.x); EpiResF32 e{gR, out, D_}; gemm_phase<EpiResF32, StaticOrder, false>((PG8_LAS unsigned char*)smem, g, so, e, nullptr, wv); } break;
        case K_GLA_PREP: gla_prep(p, smem, wv); break;
        case K_GLA_SCAN: gla_scan(p, smem, wv); break;
        case K_ONORM: gla_onorm(p, wv); break;
        case K_ACT: ffn_act(p, layer, wv); break;
        case K_MOBA_PREP: moba_prep(p, smem, wv); break;
        case K_GATE: moba_gate(p, smem, wv); break;
        case K_ATTN: moba_attn(p, smem, wv); break;
        default: moba_combine(p, wv); break;
        }
        if (step + 1 < NSTEP) grid.sync();
    }
}

extern "C" void kernel_launch(void* const* d_in, const int* in_sizes, int n_in, void* d_out, int out_size, void* d_ws, size_t ws_size, hipStream_t stream) {
    static int grid_blocks = 0;
    if (grid_blocks == 0) {
        if (n_in != 21 || out_size != S_ * D_ || ws_size < WS_END) { fprintf(stderr, "kernel_launch: unexpected problem (n_in %d out %d ws %zu need %zu)\n", n_in, out_size, ws_size, (size_t)WS_END); grid_blocks = -1; return; }
        int dev = 0, cus = 0, per_cu = 0;
        hipGetDevice(&dev);
        hipDeviceGetAttribute(&cus, hipDeviceAttributeMultiprocessorCount, dev);
        if (hipFuncSetAttribute((const void*)fwd_kernel, hipFuncAttributeMaxDynamicSharedMemorySize, LDS_BYTES) != hipSuccess) { fprintf(stderr, "kernel_launch: hipFuncSetAttribute failed\n"); grid_blocks = -1; return; }
        if (hipOccupancyMaxActiveBlocksPerMultiprocessor(&per_cu, (const void*)fwd_kernel, 512, LDS_BYTES) != hipSuccess || per_cu < 1) { fprintf(stderr, "kernel_launch: occupancy query says %d\n", per_cu); per_cu = 1; (void)hipGetLastError(); }
        grid_blocks = cus * per_cu;
    }
    if (grid_blocks < 0) return;
    Params p{};
    for (int i = 0; i < 21; ++i) p.in[i] = (const float*)d_in[i];
    p.out = (float*)d_out; p.ws = (unsigned char*)d_ws;
    void* args[] = {&p};
    hipError_t e = hipLaunchCooperativeKernel((const void*)fwd_kernel, dim3(grid_blocks), dim3(512), args, LDS_BYTES, stream);
    if (e != hipSuccess) fprintf(stderr, "cooperative launch failed: %s (grid %d)\n", hipGetErrorString(e), grid_blocks);
}
```

```cpp
#include <hip/hip_runtime.h>
#include <hip/hip_cooperative_groups.h>
#include <cstdio>
namespace cg = cooperative_groups;
__device__ __forceinline__ int opaque_tid(int wv) { int t = __builtin_amdgcn_mbcnt_hi(~0u, __builtin_amdgcn_mbcnt_lo(~0u, 0u)); asm volatile("" : "+v"(t)); return wv * 64 + t; }
namespace pg8 {
#define PG8_LAS __attribute__((address_space(3)))
typedef unsigned short bf16_t;
typedef short bf16x8 __attribute__((ext_vector_type(8)));
typedef float f32x4 __attribute__((ext_vector_type(4)));
typedef unsigned u32x4 __attribute__((ext_vector_type(4)));
constexpr int BM = 256, BK = 64, HALF = 128, HTB = HALF * BK * 2  , STAGE_BYTES = 8 * HTB, NXCD = 8, WGM = 8;

__host__ __device__ __forceinline__ int lds_byte(int r, int c) { const int st = (r >> 4) * 2 + (c >> 5), rr = r & 15, cc = c & 31, ob = rr * 64 + cc * 2; return st * 1024 + (ob ^ (((ob >> 9) & 1) << 5)); }
__host__ __device__ __forceinline__ void stage_rc(int b, int& R, int& C) { const int st = b / 1024, sb = b % 1024, swz = sb ^ (((sb >> 9) & 1) << 5); R = (st >> 1) * 16 + swz / 64; C = (st & 1) * 32 + (swz % 64) / 2; }
__host__ __device__ __forceinline__ int perm32(int rho) { const int n = rho >> 4, i = rho & 15; return 8 * (i >> 2) + 4 * n + (i & 3); }

struct Unit { int pm, pn; };
struct Gemm { const bf16_t* A; const bf16_t* Bt; int M, N, K; };
struct StaticOrder {
    int nM, nN, nwg, G, c;
    __host__ __device__ void init(int M, int N, int G_, int c_) { nM = M / BM; nN = N / BM; nwg = nM * nN; G = G_; c = c_; }
    __host__ __device__ bool next(int i, Unit& u) const {
        const long L = (long)i * G + c; if (L >= nwg) return false;
        int wgid = (int)L; { const int q = nwg / NXCD, r = nwg % NXCD, xcd = wgid % NXCD, off = wgid / NXCD; wgid = (xcd < r ? xcd * (q + 1) : r * (q + 1) + (xcd - r) * q) + off; }
        const int nig = WGM * nN, gid = wgid / nig, fm = gid * WGM, gsz = (nM - fm) < WGM ? (nM - fm) : WGM;
        u.pm = fm + ((wgid % nig) % gsz); u.pn = (wgid % nig) / gsz; return true;
    }
    __device__ __forceinline__ void a_ready(const Unit&) const {}
    __device__ __forceinline__ void done(const Unit&) const {}
};
__device__ __forceinline__ unsigned cvt_pk_bf16(float lo, float hi) { unsigned r; asm volatile("v_cvt_pk_bf16_f32 %0, %1, %2" : "=v"(r) : "v"(lo), "v"(hi)); return r; }

template <class Epi, class Sched, bool STAMP = false>
__device__ __forceinline__ void gemm_phase(PG8_LAS unsigned char* lds, const Gemm g, const Sched& S, const Epi& E, unsigned long long* stamps, int wv) {
    const int tid = opaque_tid(wv), wid = __builtin_amdgcn_readfirstlane(tid >> 6), lane = tid & 63, wr = wid >> 2, wc = wid & 3, fr = lane & 15, fq = lane >> 4;
    const int K = g.K, nt = K / BK;
    int ts_lo = 0, ts_hi = 0, nts = 0; const unsigned long long rt_entry = STAMP ? (unsigned long long)wall_clock64() : 0ull;
#define PG8_STAMP() do { if (STAMP && wid == 0 && nts < 64) { const unsigned long long _c = (unsigned long long)clock64(); \
        ts_lo = (lane == nts) ? (int)(unsigned)_c : ts_lo; ts_hi = (lane == nts) ? (int)(unsigned)(_c >> 32) : ts_hi; ++nts; } } while (0)
    PG8_STAMP();
    unsigned voffA[2], voffB[2];
#pragma unroll
    for (int i = 0; i < 2; ++i) { int R, C; stage_rc(tid * 16 + i * 8192, R, C); const int Rb = Epi::PERM ? ((R & ~31) + perm32(R & 31)) : R;
        voffA[i] = (unsigned)(R * K + C) * 2u; voffB[i] = (unsigned)(Rb * K + C) * 2u; }
    const size_t kstep = (size_t)(BK * 2);
    const size_t hstep = (size_t)HALF * K * 2;
    const size_t tstep = 2 * hstep;
    const unsigned ldsw = (unsigned)wid * 1024u;
    const int aoff = lds_byte(wr * 64 + fr, fq * 8), boff = lds_byte(wc * 32 + fr, fq * 8);
#define PG8_SA(b, h) (((b) * 2 + (h)) * HTB)
#define PG8_SB(b, h) ((4 + (b) * 2 + (h)) * HTB)
#define PG8_STAGE(bufoff, gbase, voff) do { _Pragma("unroll") for (int _i = 0; _i < 2; ++_i) \
        __builtin_amdgcn_global_load_lds((const unsigned*)((const char*)(gbase) + (voff)[_i]), (PG8_LAS unsigned*)(lds + (bufoff) + ldsw + _i * 8192), 16, 0, 0); } while (0)
#define PG8_LDA(dst, b, h) do { _Pragma("unroll") for (int m = 0; m < 4; ++m) _Pragma("unroll") for (int k = 0; k < 2; ++k) dst[m][k] = *(const PG8_LAS bf16x8*)(lds + PG8_SA(b, h) + aoff + m * 2048 + k * 1024); } while (0)
#define PG8_LDB(dst, b, h) do { _Pragma("unroll") for (int n = 0; n < 2; ++n) _Pragma("unroll") for (int k = 0; k < 2; ++k) dst[n][k] = *(const PG8_LAS bf16x8*)(lds + PG8_SB(b, h) + boff + n * 2048 + k * 1024); } while (0)
#define PG8_MMA(ai, bj, At, Bt) do { __builtin_amdgcn_s_setprio(1); _Pragma("unroll") for (int m = 0; m < 4; ++m) _Pragma("unroll") for (int n = 0; n < 2; ++n) _Pragma("unroll") for (int k = 0; k < 2; ++k) \
        acc[ai][bj][m][n] = __builtin_amdgcn_mfma_f32_16x16x32_bf16(Bt[n][k], At[m][k], acc[ai][bj][m][n], 0, 0, 0); __builtin_amdgcn_s_setprio(0); } while (0)
#define PG8_WAIT_V(n) asm volatile("s_waitcnt vmcnt(" #n ")" ::: "memory")
#define PG8_WAIT_L(n) asm volatile("s_waitcnt lgkmcnt(" #n ")" ::: "memory")
#define PG8_BAR __builtin_amdgcn_s_barrier()
#define PG8_SCHED __builtin_amdgcn_sched_barrier(0)
    Unit cur, nxt; int ui = 0;
    if (!S.next(0, cur)) return;
    f32x4 acc[2][2][4][2];
#pragma unroll
    for (int a = 0; a < 2; ++a)
#pragma unroll
        for (int b = 0; b < 2; ++b)
#pragma unroll
            for (int m = 0; m < 4; ++m)
#pragma unroll
                for (int n = 0; n < 2; ++n) acc[a][b][m][n] = (f32x4){0.f, 0.f, 0.f, 0.f};
    bf16x8 At[4][2], B0[2][2], B1[2][2];
    const char* cA = (const char*)g.A + (size_t)cur.pm * tstep; const char* cB = (const char*)g.Bt + (size_t)cur.pn * tstep;
    S.a_ready(cur);
    PG8_STAGE(PG8_SB(0, 0), cB, voffB); PG8_STAGE(PG8_SA(0, 0), cA, voffA); PG8_STAGE(PG8_SB(0, 1), cB + hstep, voffB); PG8_STAGE(PG8_SA(0, 1), cA + hstep, voffA);
    if (wr == 1) PG8_BAR;
    PG8_WAIT_V(4); PG8_BAR;
    PG8_STAGE(PG8_SB(1, 0), cB + kstep, voffB); PG8_STAGE(PG8_SA(1, 0), cA + kstep, voffA); PG8_STAGE(PG8_SB(1, 1), cB + hstep + kstep, voffB);
    PG8_WAIT_V(6); PG8_BAR;
    PG8_STAMP();
    for (;;) {
        const bool has_next = S.next(ui + 1, nxt);
        const char* nA = has_next ? (const char*)g.A + (size_t)nxt.pm * tstep : cA; const char* nB = has_next ? (const char*)g.Bt + (size_t)nxt.pn * tstep : cB;
        for (int t = 0; t < nt; t += 2) {
            const bool last = (t == nt - 2);
            const char* a1 = cA + (size_t)(t + 1) * kstep;
            const char* a2 = last ? nA : cA + (size_t)(t + 2) * kstep; const char* b2 = last ? nB : cB + (size_t)(t + 2) * kstep;
            const char* a3 = a2 + kstep; const char* b3 = b2 + kstep;
            if (last && has_next) S.a_ready(nxt);
            PG8_LDB(B0, 0, 0); PG8_SCHED; PG8_LDA(At, 0, 0); PG8_STAGE(PG8_SA(1, 1), a1 + hstep, voffA);
            PG8_WAIT_L(8); PG8_BAR; PG8_WAIT_L(0); PG8_MMA(0, 0, At, B0); PG8_BAR; PG8_SCHED;
            PG8_LDB(B1, 0, 1); PG8_STAGE(PG8_SB(0, 0), b2, voffB);
            PG8_BAR; PG8_WAIT_L(0); PG8_MMA(0, 1, At, B1); PG8_BAR;
            PG8_LDA(At, 0, 1); PG8_STAGE(PG8_SA(0, 0), a2, voffA);
            PG8_BAR; PG8_WAIT_L(0); PG8_MMA(1, 0, At, B0); PG8_BAR; PG8_SCHED;
            PG8_STAGE(PG8_SB(0, 1), b2 + hstep, voffB);
            PG8_WAIT_V(6); PG8_BAR; PG8_MMA(1, 1, At, B1); PG8_BAR;
            PG8_LDB(B0, 1, 0); PG8_SCHED; PG8_LDA(At, 1, 0); PG8_STAGE(PG8_SA(0, 1), a2 + hstep, voffA);
            PG8_WAIT_L(8); PG8_BAR; PG8_WAIT_L(0); PG8_MMA(0, 0, At, B0); PG8_BAR; PG8_SCHED;
            PG8_LDB(B1, 1, 1); PG8_STAGE(PG8_SB(1, 0), b3, voffB);
            PG8_BAR; PG8_WAIT_L(0); PG8_MMA(0, 1, At, B1); PG8_BAR;
            PG8_LDA(At, 1, 1); PG8_STAGE(PG8_SA(1, 0), a3, voffA);
            PG8_BAR; PG8_WAIT_L(0); PG8_MMA(1, 0, At, B0); PG8_BAR; PG8_SCHED;
            PG8_STAGE(PG8_SB(1, 1), b3 + hstep, voffB);
            PG8_WAIT_V(6); PG8_BAR; PG8_MMA(1, 1, At, B1); PG8_BAR;
        }
        PG8_STAMP();
        if constexpr (!Epi::AFTER_DRAIN) { E(acc, cur, wr, wc, fr, fq); S.done(cur); }
        PG8_STAMP();
        if (!has_next) break;
#pragma unroll
        for (int a = 0; a < 2; ++a)
#pragma unroll
            for (int b = 0; b < 2; ++b)
#pragma unroll
                for (int m = 0; m < 4; ++m)
#pragma unroll
                    for (int n = 0; n < 2; ++n) acc[a][b][m][n] = (f32x4){0.f, 0.f, 0.f, 0.f};
        cur = nxt; cA = nA; cB = nB; ++ui;
    }
    PG8_WAIT_V(0);
    if (wr == 0) PG8_BAR;
    PG8_BAR;
    if constexpr (Epi::AFTER_DRAIN) { E.fused(acc, cur, wr, wc, fr, fq, lds, wid, lane); S.done(cur); }
    PG8_STAMP();
    if (STAMP && wid == 0) { stamps[lane] = lane < nts ? (((unsigned long long)(unsigned)ts_hi << 32) | (unsigned)ts_lo) : 0ull;
        if (lane == 62) stamps[62] = rt_entry; if (lane == 63) stamps[63] = (unsigned long long)wall_clock64(); }
#undef PG8_STAMP
#undef PG8_SA
#undef PG8_SB
#undef PG8_STAGE
#undef PG8_LDA
#undef PG8_LDB
#undef PG8_MMA
#undef PG8_WAIT_V
#undef PG8_WAIT_L
#undef PG8_BAR
#undef PG8_SCHED
}
}
#define XB_TMO      128
#define XB_XCNT(j)  (256  + 64 * (j))
#define XB_XSUB(j)  (1280 + 64 * (j))
#define XB_XGEN(j)  (2304 + 64 * (j))
#define XB_TOP      3328
#define XB_TOPGEN   3392
#define XCD_BAR_WORDS 3456
#define XB_SPIN_CAP (1u << 18)
#define LAS __attribute__((address_space(3)))

__device__ __forceinline__ unsigned xb_ld(unsigned* p)              { return __hip_atomic_load(p, __ATOMIC_RELAXED, __HIP_MEMORY_SCOPE_AGENT); }
__device__ __forceinline__ unsigned xb_add(unsigned* p, unsigned v) { return __hip_atomic_fetch_add(p, v, __ATOMIC_RELAXED, __HIP_MEMORY_SCOPE_AGENT); }
__device__ __forceinline__ unsigned xb_xcc_id() { return (unsigned)__builtin_amdgcn_s_getreg((3 << 11) | 20) & 0xFu; }
#define XB_SPIN(cond, bar) do { unsigned _sp = 0; while (cond) { __builtin_amdgcn_s_sleep(1); \
    if ((++_sp & 255u) == 0u) { if (xb_ld(&(bar)[XB_TMO])) break; if (_sp > XB_SPIN_CAP) { atomicAdd(&(bar)[XB_TMO], 1u); break; } } } } while (0)

struct XcdBarrier {
    unsigned* bar; unsigned x;
    volatile LAS unsigned* st;
};

__device__ __forceinline__ XcdBarrier xcd_barrier_post(unsigned* bar, volatile LAS unsigned* st) {
    XcdBarrier b; b.bar = bar; b.x = xb_xcc_id(); b.st = st;
    if (threadIdx.x == 0) (void)xb_add(&bar[XB_XCNT(b.x)], 1u);
    return b;
}
__device__ __forceinline__ void xcd_barrier_complete(unsigned* bar, unsigned x, unsigned& nloc, unsigned& nx) {
    const unsigned G = gridDim.x * gridDim.y * gridDim.z;
    unsigned sum, cnt, mine, sp = 0u;
    for (;;) {
        sum = 0u; cnt = 0u; mine = 0u;
#pragma unroll
        for (unsigned j = 0; j < 16; ++j) { const unsigned c = xb_ld(&bar[XB_XCNT(j)]); sum += c; cnt += (c > 0u) ? 1u : 0u; mine = (j == x) ? c : mine; }
        if (sum == G) break;
        __builtin_amdgcn_s_sleep(1);
        if ((++sp & 255u) == 0u) { if (xb_ld(&bar[XB_TMO])) break; if (sp > XB_SPIN_CAP) { atomicAdd(&bar[XB_TMO], 1u); break; } }
    }
    nloc = mine > 0u ? mine : 1u; nx = cnt > 0u ? cnt : 1u;
}

__device__ __forceinline__ void xcd_barrier(const XcdBarrier& b) {
    asm volatile("s_waitcnt vmcnt(0)" ::: "memory");
    __syncthreads();
    if (threadIdx.x == 0) {
        unsigned* bar = b.bar;
        __builtin_amdgcn_s_waitcnt(0);
        unsigned nloc = b.st[0], nx = b.st[1];
        if (nloc == 0u) { xcd_barrier_complete(bar, b.x, nloc, nx); b.st[0] = nloc; b.st[1] = nx; }
        const unsigned old = xb_add(&bar[XB_XSUB(b.x)], 1u);
        const unsigned gen = old / nloc;
        if (old + 1u == (gen + 1u) * nloc) {
            __builtin_amdgcn_fence(__ATOMIC_RELEASE, "agent");
            asm volatile("s_waitcnt vmcnt(0)" ::: "memory");
            const unsigned og = xb_add(&bar[XB_TOP], 1u);
            const unsigned tg = og / nx;
            if (og + 1u == (tg + 1u) * nx) xb_add(&bar[XB_TOPGEN], 1u);
            else XB_SPIN(xb_ld(&bar[XB_TOPGEN]) == tg, bar);
            __builtin_amdgcn_fence(__ATOMIC_ACQUIRE, "agent");
            xb_add(&bar[XB_XGEN(b.x)], 1u);
            asm volatile("s_waitcnt vmcnt(0)" ::: "memory");
        } else {
            XB_SPIN(xb_ld(&bar[XB_XGEN(b.x)]) == gen, bar);
            __builtin_amdgcn_fence(__ATOMIC_ACQUIRE, "agent");
            asm volatile("s_waitcnt vmcnt(0)" ::: "memory");
        }
    }
    __syncthreads();
}

using namespace pg8;
typedef unsigned int u32;
typedef float f32x2 __attribute__((ext_vector_type(2)));

constexpr int S_ = 16384, D_ = 2048, NPROJ = 6144, F_ = 5632, F2_ = 11264, NH = 16, DH = 128;
constexpr size_t OFF_W = 0;
constexpr size_t OFF_BIG = 46137344;
constexpr size_t OFF_A3 = OFF_BIG + 369098752;
constexpr size_t OFF_SM = OFF_A3 + 184549376;
constexpr size_t OFF_GK1 = OFF_SM;
constexpr size_t OFF_DECAY = OFF_GK1 + 1048576;
constexpr size_t OFF_KMEAN = OFF_DECAY + 1048576;
constexpr size_t OFF_SEL = OFF_KMEAN + 524288;
constexpr size_t OFF_CNT = OFF_SEL + 1048576;
constexpr size_t OFF_CTR = OFF_CNT + 4096;
constexpr size_t OFF_ML = OFF_CTR + 256;
constexpr size_t WS_END = OFF_ML + 8388608;
constexpr size_t OFF_X0 = WS_END;
constexpr size_t OFF_X1 = OFF_X0 + 8388608;
constexpr size_t OFF_X2 = OFF_X1 + 46137344;
constexpr size_t OFF_X3 = OFF_X2 + 23068672;
constexpr size_t WS_END2 = OFF_X3 + 25165824;
constexpr size_t OFF_POSIDX = OFF_X0;
constexpr size_t OFF_BASEG = OFF_SEL;
constexpr size_t OFF_ST = OFF_X0 + 4194304;
constexpr size_t OFF_ATT = OFF_X1;
constexpr size_t OFF_BAR = WS_END2;
constexpr size_t OFF_PROJ = OFF_BIG;
constexpr size_t OFF_QDEC = OFF_BIG + 201326592;
constexpr size_t OFF_KENDT = OFF_QDEC + 33554432;
constexpr size_t OFF_VT = OFF_KENDT + 33554432;
constexpr size_t OFF_A1 = OFF_VT;
constexpr size_t OFF_VTM = OFF_BIG + 268435456;
constexpr size_t OFF_LISTS = OFF_BIG + 335544320;
constexpr size_t OFF_OPART = OFF_BIG;
constexpr size_t OFF_HALO = OFF_BIG + 184549376;
constexpr size_t OFF_KN = OFF_A3 + 67108864;
constexpr int LDS_BYTES = 163840;

struct Params { const float* in[21]; float* out; unsigned char* ws; long long overlap; };

__device__ __forceinline__ float bf2f(u32 b) { return __uint_as_float(b << 16); }
__device__ __forceinline__ float bflo(u32 w) { return __uint_as_float(w << 16); }
__device__ __forceinline__ float bfhi(u32 w) { return __uint_as_float(w & 0xffff0000u); }
__device__ __forceinline__ bf16_t f2bf(float f) { u32 u = __float_as_uint(f); u += 0x7FFFu + ((u >> 16) & 1u); return (bf16_t)(u >> 16); }
__device__ __forceinline__ u32 pk2(float lo, float hi) { return (u32)f2bf(lo) | ((u32)f2bf(hi) << 16); }
__device__ __forceinline__ float wave_sum(float v) {
#pragma unroll
    for (int o = 32; o; o >>= 1) v += __shfl_xor(v, o);
    return v;
}
__device__ __forceinline__ bf16x8 as_bf8(uint4 v) { return __builtin_bit_cast(bf16x8, v); }
__device__ __forceinline__ f32x4 mfma16(bf16x8 a, bf16x8 b, f32x4 c) { return __builtin_amdgcn_mfma_f32_16x16x32_bf16(a, b, c, 0, 0, 0); }

struct EpiBf16P {
    static constexpr bool PERM = true, AFTER_DRAIN = false;
    bf16_t* O; int ldc;
    __device__ __forceinline__ void operator()(const f32x4 (&acc)[2][2][4][2], const Unit& u, int wr, int wc, int fr, int fq) const {
        const int row0 = u.pm * BM + wr * 64 + fr; const int col0 = u.pn * BM + wc * 32 + 8 * fq;
#pragma unroll
        for (int ai = 0; ai < 2; ++ai)
#pragma unroll
            for (int m = 0; m < 4; ++m) { bf16_t* rowp = O + (size_t)(row0 + ai * HALF + m * 16) * ldc + col0;
#pragma unroll
                for (int bj = 0; bj < 2; ++bj) { const f32x4 v0 = acc[ai][bj][m][0], v1 = acc[ai][bj][m][1];
                    uint4 w; w.x = cvt_pk_bf16(v0[0], v0[1]); w.y = cvt_pk_bf16(v0[2], v0[3]); w.z = cvt_pk_bf16(v1[0], v1[1]); w.w = cvt_pk_bf16(v1[2], v1[3]);
                    *(uint4*)(rowp + bj * HALF) = w; } }
    }
};
struct EpiResF32 {
    static constexpr bool PERM = false, AFTER_DRAIN = false;
    const float* R; float* C; int ldc;
    __device__ __forceinline__ void operator()(const f32x4 (&acc)[2][2][4][2], const Unit& u, int wr, int wc, int fr, int fq) const {
        const int row0 = u.pm * BM + wr * 64 + fr, col0 = u.pn * BM + wc * 32 + 4 * fq;
#pragma unroll
        for (int ai = 0; ai < 2; ++ai)
#pragma unroll
            for (int m = 0; m < 4; ++m) { const size_t ro = (size_t)(row0 + ai * HALF + m * 16) * ldc + col0;
#pragma unroll
                for (int bj = 0; bj < 2; ++bj)
#pragma unroll
                    for (int n = 0; n < 2; ++n) { const f32x4 r = *(const f32x4*)(R + ro + bj * HALF + n * 16); *(f32x4*)(C + ro + bj * HALF + n * 16) = acc[ai][bj][m][n] + r; } }
    }
};


template <int CTRL> __device__ __forceinline__ float dppz(float x) { return __builtin_bit_cast(float, __builtin_amdgcn_update_dpp(0, __builtin_bit_cast(int, x), CTRL, 0xf, 0xf, true)); }
struct EpiConvAct {
    static constexpr bool PERM = true, AFTER_DRAIN = false;
    bf16_t* act; bf16_t* halo; const float* cw; const float* cb;
    __device__ __forceinline__ void operator()(const f32x4 (&acc)[2][2][4][2], const Unit& u, int wr, int wc, int fr, int fq) const {
        const int fcol = u.pn * 128 + wc * 32 + 8 * fq;
        uint2 outp[2][4][2];
#pragma unroll
        for (int n = 0; n < 2; ++n) { const int f = fcol + 4 * n;
            const f32x4 wa0 = *(const f32x4*)(cw + f), wa1 = *(const f32x4*)(cw + F2_ + f), wa2 = *(const f32x4*)(cw + 2 * F2_ + f), ba = *(const f32x4*)(cb + f);
            const f32x4 wu0 = *(const f32x4*)(cw + F_ + f), wu1 = *(const f32x4*)(cw + F2_ + F_ + f), wu2 = *(const f32x4*)(cw + 2 * F2_ + F_ + f), bu = *(const f32x4*)(cb + F_ + f);
#pragma unroll
            for (int ai = 0; ai < 2; ++ai) { const int g = u.pm * 4 + ai * 2 + wr;
#pragma unroll
                for (int m = 0; m < 4; ++m) { const f32x4 xa = acc[ai][0][m][n], xu = acc[ai][1][m][n];
                    const f32x4 pa = m > 0 ? acc[ai][0][m > 0 ? m - 1 : 0][n] : (f32x4){0.f, 0.f, 0.f, 0.f}, pu = m > 0 ? acc[ai][1][m > 0 ? m - 1 : 0][n] : (f32x4){0.f, 0.f, 0.f, 0.f};
                    float o[4];
#pragma unroll
                    for (int jj = 0; jj < 4; ++jj) {
                        const float a1 = dppz<0x121>(fr == 15 ? pa[jj] : xa[jj]), a2 = dppz<0x122>(fr >= 14 ? pa[jj] : xa[jj]);
                        const float u1 = dppz<0x121>(fr == 15 ? pu[jj] : xu[jj]), u2 = dppz<0x122>(fr >= 14 ? pu[jj] : xu[jj]);
                        const float A = ba[jj] + wa0[jj] * a2 + wa1[jj] * a1 + wa2[jj] * xa[jj], U = bu[jj] + wu0[jj] * u2 + wu1[jj] * u1 + wu2[jj] * xu[jj];
                        o[jj] = A * __builtin_amdgcn_rcpf(1.0f + __expf(-A)) * U; }
                    outp[ai][m][n] = make_uint2(cvt_pk_bf16(o[0], o[1]), cvt_pk_bf16(o[2], o[3]));
                    if ((m == 0 && fr < 2) || (m == 3 && fr >= 14)) { const int slot = (m == 0) ? fr : fr - 12;
                        bf16_t* hp = halo + (size_t)((g * 4 + slot) * 2) * F_ + f;
                        *(uint2*)hp = make_uint2(cvt_pk_bf16(xa[0], xa[1]), cvt_pk_bf16(xa[2], xa[3]));
                        *(uint2*)(hp + F_) = make_uint2(cvt_pk_bf16(xu[0], xu[1]), cvt_pk_bf16(xu[2], xu[3])); } } } }
        const int row0 = u.pm * BM + wr * 64 + fr;
#pragma unroll
        for (int ai = 0; ai < 2; ++ai)
#pragma unroll
            for (int m = 0; m < 4; ++m) if (!(m == 0 && fr < 2))
                *(uint4*)(act + (size_t)(row0 + ai * HALF + m * 16) * F_ + fcol) = make_uint4(outp[ai][m][0].x, outp[ai][m][0].y, outp[ai][m][1].x, outp[ai][m][1].y);
    }
};

struct ConvJob { const float* W; const float* gain; bf16_t* dst; int K, N; int perm; };
__device__ __forceinline__ void conv_job(const ConvJob j, float* lds, int wv, int worker, int nworkers) {
    if (!j.W) return;
    const int tid = opaque_tid(wv);
    const int ntn = j.N >> 7, nt = ntn * (j.K >> 6);
    for (int tile = worker * 2; tile < nt; tile += nworkers * 2) {
        const int k0 = (tile / ntn) << 6, n0 = (tile % ntn) << 7;
        float4 v[2][4];
#pragma unroll
        for (int hh = 0; hh < 2; ++hh)
#pragma unroll
            for (int i = 0; i < 4; ++i) { const int idx = tid + i * 512, kk = idx >> 5, n4 = idx & 31;
                v[hh][i] = *(const float4*)(j.W + (size_t)(k0 + kk) * j.N + n0 + hh * 128 + n4 * 4); }
        if (j.gain) {
#pragma unroll
            for (int i = 0; i < 4; ++i) { const float g = j.gain[k0 + ((tid + i * 512) >> 5)];
#pragma unroll
                for (int hh = 0; hh < 2; ++hh) { v[hh][i].x *= g; v[hh][i].y *= g; v[hh][i].z *= g; v[hh][i].w *= g; } } }
        __syncthreads();
#pragma unroll
        for (int hh = 0; hh < 2; ++hh)
#pragma unroll
            for (int i = 0; i < 4; ++i) { const int idx = tid + i * 512, kk = idx >> 5, n4 = idx & 31; float* d = lds + hh * 8320 + (n4 * 4) * 65 + kk;
                d[0] = v[hh][i].x; d[65] = v[hh][i].y; d[130] = v[hh][i].z; d[195] = v[hh][i].w; }
        __syncthreads();
#pragma unroll
        for (int hh = 0; hh < 2; ++hh)
#pragma unroll
            for (int i = 0; i < 2; ++i) { const int idx = tid + i * 512, n = idx >> 3, kg = idx & 7; const float* s = lds + hh * 8320 + n * 65 + kg * 8;
                uint4 w; w.x = pk2(s[0], s[1]); w.y = pk2(s[2], s[3]); w.z = pk2(s[4], s[5]); w.w = pk2(s[6], s[7]);
                const int nb = n0 + hh * 128, rb = j.perm ? (nb < F_ ? (nb >> 7) * 256 : ((nb - F_) >> 7) * 256 + 128) : nb;
                *(uint4*)(j.dst + (size_t)(rb + n) * j.K + k0 + kg * 8) = w; }
    }
    __syncthreads();
}

template <bool GK>
__device__ __forceinline__ void norm_rows(const float* X, bf16_t* Y, const float* w1, const float* g, float* gk1, float* lds, int wv) {
    const int tid = opaque_tid(wv), lane = tid & 63, wid = tid >> 6;
    if (GK) { for (int e = tid; e < 32768; e += 512) { const int k = e >> 4, r = e & 15; lds[r * 2048 + k] = w1[e] * g[k]; } __syncthreads(); }
    const int nw = gridDim.x * 8;
    for (int t = blockIdx.x * 8 + wid; t < S_; t += nw) {
        float4 x[8]; float ss = 0.f;
#pragma unroll
        for (int i = 0; i < 8; ++i) { x[i] = *(const float4*)(X + (size_t)t * D_ + (i * 64 + lane) * 4); ss += x[i].x * x[i].x + x[i].y * x[i].y + x[i].z * x[i].z + x[i].w * x[i].w; }
        ss = wave_sum(ss);
        const float rinv = rsqrtf(ss * (1.0f / D_) + 1e-6f);
#pragma unroll
        for (int i = 0; i < 8; ++i) { uint2 w; w.x = pk2(x[i].x * rinv, x[i].y * rinv); w.y = pk2(x[i].z * rinv, x[i].w * rinv); *(uint2*)(Y + (size_t)t * D_ + (i * 64 + lane) * 4) = w; }
        if (GK) {
            float outv = 0.f;
#pragma unroll 2
            for (int r = 0; r < 16; ++r) { float a = 0.f;
#pragma unroll
                for (int i = 0; i < 8; ++i) { const float4 w = *(const float4*)(lds + r * 2048 + (i * 64 + lane) * 4); a += x[i].x * w.x + x[i].y * w.y + x[i].z * w.z + x[i].w * w.w; }
                a = wave_sum(a); if (lane == r) outv = a; }
            if (lane < 16) gk1[(size_t)t * 16 + lane] = outv * rinv;
        }
    }
    if (GK) __syncthreads();
}

__device__ __forceinline__ void gla_prep(const Params& p, unsigned char* smem, int wv) {
    const int tid = opaque_tid(wv), lane = tid & 63, wid = tid >> 6, fr = lane & 15, fq = lane >> 4;
    const bf16_t* proj = (const bf16_t*)(p.ws + OFF_PROJ);
    bf16_t* qdec = (bf16_t*)(p.ws + OFF_QDEC); bf16_t* kendT = (bf16_t*)(p.ws + OFF_KENDT); bf16_t* vTg = (bf16_t*)(p.ws + OFF_VT);
    const float* gk1 = (const float*)(p.ws + OFF_GK1); float* decay = (float*)(p.ws + OFF_DECAY);
    const float* gk_w2 = p.in[4]; const float* gk_b = p.in[5];
    bf16_t* sVT = (bf16_t*)smem; bf16_t* sQ = (bf16_t*)(smem + 73728); bf16_t* sK = (bf16_t*)(smem + 107520); bf16_t* sAt = (bf16_t*)(smem + 141312);
    float* sTot = (float*)(smem + 150528); float* sG = (float*)(smem + 152576);
    for (int u = blockIdx.x; u < 1024; u += gridDim.x) {
        const int h = u & 3, n = u >> 2, t0 = n * 64;
        for (int e = tid; e < 1024; e += 512) { const int s = e >> 4, r = e & 15; sG[(s >> 1) * 32 + r * 2 + (s & 1)] = gk1[(size_t)t0 * 16 + e]; }
#pragma unroll
        for (int i = 0; i < 4; ++i) { const int id = tid + i * 512, row = id >> 5, piece = id & 31;
            const bf16_t* src = proj + (size_t)(t0 + row) * NPROJ + h * 256 + piece * 8;
            *(uint4*)(sQ + row * 264 + piece * 8) = *(const uint4*)src; *(uint4*)(sK + row * 264 + piece * 8) = *(const uint4*)(src + 1024); }
        __syncthreads();
        const int c = tid & 255, half = tid >> 8;
        float bl[32];
        { float w2c[16];
#pragma unroll
          for (int r = 0; r < 16; ++r) w2c[r] = gk_w2[r * 1024 + h * 256 + c];
          const float bias = gk_b[h * 256 + c]; float run = 0.f;
#pragma unroll
          for (int i = 0; i < 32; i += 2) { if ((i & 3) == 0) asm volatile("" ::: "memory");
              const f32x4* gr = (const f32x4*)(sG + (half * 16 + (i >> 1)) * 32); f32x2 gv = {bias, bias};
#pragma unroll
              for (int r = 0; r < 16; r += 2) { const f32x4 g4 = gr[r >> 1]; gv += (f32x2){g4[0], g4[1]} * w2c[r]; gv += (f32x2){g4[2], g4[3]} * w2c[r + 1]; }
              run += (fminf(gv[0], 0.f) - __logf(1.0f + __expf(-fabsf(gv[0])))) * 0.0625f; bl[i] = run;
              run += (fminf(gv[1], 0.f) - __logf(1.0f + __expf(-fabsf(gv[1])))) * 0.0625f; bl[i + 1] = run; }
          sTot[half * 256 + c] = run; }
        __syncthreads();
        const float blast = sTot[c] + sTot[256 + c], boff = half ? sTot[c] : 0.f, eblast = __expf(blast);
        if (half == 0) decay[(size_t)(h * 256 + n) * 256 + c] = eblast;
#pragma unroll
        for (int i = 0; i < 32; ++i) { const int s = half * 32 + i; const float eb = __expf(bl[i] + boff);
            const float qv = bf2f(sQ[s * 264 + c]), kv = bf2f(sK[s * 264 + c]);
            const u32 pkd = cvt_pk_bf16(qv * 0.0625f * eb, kv * __builtin_amdgcn_rcpf(eb)); sQ[s * 264 + c] = (bf16_t)(pkd & 0xffffu); sK[s * 264 + c] = (bf16_t)(pkd >> 16); }
        __syncthreads();
#pragma unroll
        for (int i = 0; i < 4; ++i) { const int id = tid + i * 512, row = id >> 5, piece = id & 31;
            *(uint4*)(qdec + (size_t)(t0 + row) * 1024 + h * 256 + piece * 8) = *(const uint4*)(sQ + row * 264 + piece * 8); }
#pragma unroll
        for (int tt = 0; tt < 2; ++tt) { const int id = wid + tt * 8, st = id >> 2, qt = id & 3;
            f32x4 acc = {0.f, 0.f, 0.f, 0.f};
            if (st <= qt) {
#pragma unroll
                for (int ks = 0; ks < 8; ++ks) { const bf16x8 a = *(const bf16x8*)(sK + (st * 16 + fr) * 264 + ks * 32 + fq * 8); const bf16x8 b = *(const bf16x8*)(sQ + (qt * 16 + fr) * 264 + ks * 32 + fq * 8); acc = mfma16(a, b, acc); } }
            const int q = qt * 16 + fr, s0 = st * 16 + fq * 4;
            uint2 w; w.x = pk2(s0 <= q ? acc[0] : 0.f, s0 + 1 <= q ? acc[1] : 0.f); w.y = pk2(s0 + 2 <= q ? acc[2] : 0.f, s0 + 3 <= q ? acc[3] : 0.f);
            *(uint2*)(sAt + q * 72 + s0) = w; }
        __syncthreads();
        { u32 kp[16];
#pragma unroll
          for (int i = 0; i < 32; i += 2) kp[i >> 1] = cvt_pk_bf16(bf2f(sK[(half * 32 + i) * 264 + c]) * eblast, bf2f(sK[(half * 32 + i + 1) * 264 + c]) * eblast);
          uint4* kdst = (uint4*)(kendT + ((size_t)(h * 256 + n) * 256 + c) * 64 + half * 32);
#pragma unroll
          for (int i = 0; i < 4; ++i) kdst[i] = make_uint4(kp[4 * i], kp[4 * i + 1], kp[4 * i + 2], kp[4 * i + 3]); }
        { bf16_t* attnG = (bf16_t*)(p.ws + OFF_ATT) + ((size_t)(h * 256 + n) * 64 + (tid >> 3)) * 64 + (tid & 7) * 8;
          *(uint4*)attnG = *(const uint4*)(sAt + (tid >> 3) * 72 + (tid & 7) * 8); }
        __syncthreads();
    }
}
__device__ __forceinline__ void gla_scan(const Params& p, unsigned char* smem, int wv, bool do_store) {
    const int tid = opaque_tid(wv), lane = tid & 63, wid = tid >> 6, fr = lane & 15, fq = lane >> 4;
    const bf16_t* qdec = (const bf16_t*)(p.ws + OFF_QDEC); const bf16_t* kendT = (const bf16_t*)(p.ws + OFF_KENDT); const bf16_t* vTg = (const bf16_t*)(p.ws + OFF_VT);
    float* O = (float*)(p.ws + OFF_A3); const float* decay = (const float*)(p.ws + OFF_DECAY);
    unsigned char* sQc = smem;
    unsigned char* sKc = smem + 33792;
    unsigned char* sVc = smem + 70656;
    float* sDf = (float*)(smem + 72960);
    unsigned char* sAc = smem + 73984;
    float* sRed = (float*)(smem + 83200);
    for (int u0 = blockIdx.x; u0 < 256; u0 += gridDim.x) {
        const int xcd = u0 & 7, idx = (u0 >> 3) & 15, seg = u0 >> 7, nbeg = seg * 128, nlast = nbeg + 127;
        const int h = xcd >> 1, v0 = ((xcd & 1) * 16 + idx) * 16, kw = wid * 32;
        const bf16_t* qg = qdec + (size_t)(tid >> 3) * 1024 + h * 256 + (tid & 7) * 8;
        const bf16_t* kg = kendT + (size_t)h * 4194304 + (size_t)tid * 8;
        const bf16_t* vg = (const bf16_t*)(p.ws + OFF_PROJ) + (size_t)((tid & 127) >> 1) * NPROJ + 2048 + h * 512 + v0 + (tid & 1) * 8;
        const float* dg = decay + (size_t)h * 65536 + (tid & 63) * 4;
        unsigned char* qs = sQc + (tid >> 3) * 528 + (tid & 7) * 16;
        unsigned char* ks_ = sKc + (tid >> 3) * 144 + (tid & 7) * 16;
        unsigned short* vs_ = (unsigned short*)(sVc + ((tid & 1) * 8) * 144) + ((tid & 127) >> 1);
        unsigned char* as_ = sAc + (tid >> 3) * 144 + (tid & 7) * 16;
        const bf16_t* ag = (const bf16_t*)(p.ws + OFF_ATT) + (size_t)h * 1048576 + (size_t)tid * 8;
        const unsigned char* ard = sAc + ((wid & 3) * 16 + fr) * 144 + (wid >> 2) * 64 + fq * 16;
        const int e2 = tid * 2, oq = e2 >> 4, ov = e2 & 15;
        float* ob = O + (size_t)oq * 2048 + h * 512 + v0 + ov;
        const unsigned char* qrd = sQc + fr * 528 + (kw + fq * 4) * 2;
        const unsigned char* krd = sKc + (kw + fr) * 144 + fq * 16;
        const unsigned char* vrd = sVc + fr * 144 + fq * 16;
        const float* drd = sDf + kw + fq * 4;
        u32x4 bq[4][4], bk[4][4], bv[4], bd[4], ba[4];
        f32x4 st[2] = {{0.f, 0.f, 0.f, 0.f}, {0.f, 0.f, 0.f, 0.f}};
#define SCAN_LB1(s, n, i) bq[s][i] = *(const u32x4*)(qg + (size_t)(n) * 65536 + (i) * 64); bk[s][i] = *(const u32x4*)(kg + (size_t)(n) * 16384 + (i) * 4096);
#define SCAN_LOAD(s, n) do { SCAN_LB1(s, n, 0) SCAN_LB1(s, n, 1) SCAN_LB1(s, n, 2) SCAN_LB1(s, n, 3) \
            bv[s] = *(const u32x4*)(vg + (size_t)(n) * 393216); bd[s] = *(const u32x4*)(dg + (size_t)(n) * 256); ba[s] = *(const u32x4*)(ag + (size_t)(n) * 4096); } while (0)
#define SCAN_ST1(s, i) *(u32x4*)(qs + (i) * 128) = bq[s][i]; *(u32x4*)(ks_ + (i) * 9216) = bk[s][i];
#define SCAN_STAGE(s) do { SCAN_ST1(s, 0) SCAN_ST1(s, 1) SCAN_ST1(s, 2) SCAN_ST1(s, 3) if (tid < 128) { vs_[0] = (unsigned short)bv[s][0]; vs_[72] = (unsigned short)(bv[s][0] >> 16); vs_[144] = (unsigned short)bv[s][1]; vs_[216] = (unsigned short)(bv[s][1] >> 16); vs_[288] = (unsigned short)bv[s][2]; vs_[360] = (unsigned short)(bv[s][2] >> 16); vs_[432] = (unsigned short)bv[s][3]; vs_[504] = (unsigned short)(bv[s][3] >> 16); } if (tid < 64) *(u32x4*)(sDf + tid * 4) = bd[s]; *(u32x4*)as_ = ba[s]; } while (0)
        SCAN_LOAD(0, nbeg); SCAN_LOAD(1, nbeg + 1); SCAN_LOAD(2, nbeg + 2);
        __syncthreads();
        SCAN_STAGE(0);
        __syncthreads();
#define SCAN_BODY(s, n) do { \
            { const int np = (n) + 3 <= nlast ? (n) + 3 : nlast; SCAN_LOAD(((s) + 3) & 3, np); } \
            uint4 sw; sw.x = cvt_pk_bf16(st[0][0], st[0][1]); sw.y = cvt_pk_bf16(st[0][2], st[0][3]); sw.z = cvt_pk_bf16(st[1][0], st[1][1]); sw.w = cvt_pk_bf16(st[1][2], st[1][3]); \
            const bf16x8 sb = as_bf8(sw); \
            float* red = sRed + wid * 1024; \
            const bf16x8 v0f = *(const bf16x8*)(vrd), v1f = *(const bf16x8*)(vrd + 64); \
            _Pragma("unroll") for (int qt = 0; qt < 4; ++qt) { const uint2 a0 = *(const uint2*)(qrd + qt * 8448), a1 = *(const uint2*)(qrd + qt * 8448 + 32); \
                f32x4 op = {0.f, 0.f, 0.f, 0.f}; op = mfma16(as_bf8(make_uint4(a0.x, a0.y, a1.x, a1.y)), sb, op); \
                if (qt == (wid & 3)) op = mfma16(*(const bf16x8*)(ard), (wid >> 2) ? v1f : v0f, op); \
                _Pragma("unroll") for (int jj = 0; jj < 4; ++jj) red[(qt * 16 + fq * 4 + jj) * 16 + fr] = op[jj]; } \
            { const f32x4 d0 = *(const f32x4*)(drd), d1 = *(const f32x4*)(drd + 16); \
              f32x4 c = st[0] * d0; c = mfma16(*(const bf16x8*)(krd), v0f, c); st[0] = mfma16(*(const bf16x8*)(krd + 64), v1f, c); \
              f32x4 c2 = st[1] * d1; c2 = mfma16(*(const bf16x8*)(krd + 2304), v0f, c2); st[1] = mfma16(*(const bf16x8*)(krd + 2304 + 64), v1f, c2); } \
            __syncthreads(); \
            { float2 acc = make_float2(0.f, 0.f); \
              _Pragma("unroll") for (int w = 0; w < 8; ++w) { const float2 r = *(const float2*)(sRed + w * 1024 + e2); acc.x += r.x; acc.y += r.y; } \
              if (do_store) *(float2*)(ob + (size_t)(n) * 131072) = acc; } \
            SCAN_STAGE(((s) + 1) & 3); \
            __syncthreads(); } while (0)
        for (int n0 = nbeg; n0 < nbeg + 128; n0 += 4) { SCAN_BODY(0, n0); SCAN_BODY(1, n0 + 1); SCAN_BODY(2, n0 + 2); SCAN_BODY(3, n0 + 3); }
        if (seg == 0 && do_store) { bf16_t* STp = (bf16_t*)(p.ws + OFF_ST) + ((size_t)h * 512 + v0 + fr) * 256 + kw + fq * 4;
            *(uint2*)(STp) = make_uint2(cvt_pk_bf16(st[0][0], st[0][1]), cvt_pk_bf16(st[0][2], st[0][3]));
            *(uint2*)(STp + 16) = make_uint2(cvt_pk_bf16(st[1][0], st[1][1]), cvt_pk_bf16(st[1][2], st[1][3])); }
#undef SCAN_BODY
#undef SCAN_STAGE
#undef SCAN_LOAD
#undef SCAN_LB1
#undef SCAN_ST1
    }
}

__device__ __forceinline__ void gla_onorm(const Params& p, int wv, int nitems) {
    const int tid = opaque_tid(wv), lane = tid & 63, wid = tid >> 6;
    const float* O = (const float*)(p.ws + OFF_A3); const bf16_t* proj = (const bf16_t*)(p.ws + OFF_PROJ); bf16_t* A1 = (bf16_t*)(p.ws + OFF_A1);
    const float* onw = p.in[6];
    const float4 w0 = *(const float4*)(onw + lane * 8), w1 = *(const float4*)(onw + lane * 8 + 4);
    const int nw = gridDim.x * 8;
    for (int item = blockIdx.x * 8 + wid; item < nitems; item += nw) { const size_t t = item >> 2; const int h = item & 3;
        const float4 a = *(const float4*)(O + t * 2048 + h * 512 + lane * 8), b = *(const float4*)(O + t * 2048 + h * 512 + lane * 8 + 4);
        const uint4 g = *(const uint4*)(proj + t * NPROJ + 4096 + h * 512 + lane * 8);
        float ss = a.x * a.x + a.y * a.y + a.z * a.z + a.w * a.w + b.x * b.x + b.y * b.y + b.z * b.z + b.w * b.w;
        ss = wave_sum(ss); const float r = rsqrtf(ss * (1.0f / 512.0f) + 1e-6f);
        float o[8] = {a.x * r * w0.x, a.y * r * w0.y, a.z * r * w0.z, a.w * r * w0.w, b.x * r * w1.x, b.y * r * w1.y, b.z * r * w1.z, b.w * r * w1.w};
        const float gv[8] = {bflo(g.x), bfhi(g.x), bflo(g.y), bfhi(g.y), bflo(g.z), bfhi(g.z), bflo(g.w), bfhi(g.w)};
#pragma unroll
        for (int i = 0; i < 8; ++i) o[i] *= gv[i] * __builtin_amdgcn_rcpf(1.0f + __expf(-gv[i]));
        uint4 w; w.x = pk2(o[0], o[1]); w.y = pk2(o[2], o[3]); w.z = pk2(o[4], o[5]); w.w = pk2(o[6], o[7]);
        *(uint4*)(A1 + t * 2048 + h * 512 + lane * 8) = w; }
}

__device__ __forceinline__ void gla_scanfix(const Params& p, unsigned char* smem, int wv) {
    const int tid = opaque_tid(wv), lane = tid & 63, wid = tid >> 6, fr = lane & 15, fq = lane >> 4;
    const bf16_t* qdec = (const bf16_t*)(p.ws + OFF_QDEC); const bf16_t* ST = (const bf16_t*)(p.ws + OFF_ST);
    float* O = (float*)(p.ws + OFF_A3); const float* decay = (const float*)(p.ws + OFF_DECAY);
    bf16_t* sA = (bf16_t*)smem; float* sP = (float*)(smem + 33792);
    float pr = 1.f; int jdone = 128;
    for (int u = blockIdx.x; u < 512; u += gridDim.x) { const int h = u & 3, n = 128 + (u >> 2);
        if ((gridDim.x & 3) != 0) { pr = 1.f; jdone = 128; }
        if (tid < 256) { const float* dp = decay + (size_t)(h * 256 + jdone) * 256 + tid;
#pragma unroll 8
            for (int j = jdone; j < n; ++j) { pr *= *dp; dp += 256; }
            sP[tid] = pr; }
        jdone = n;
        __syncthreads();
#pragma unroll
        for (int i = 0; i < 4; ++i) { const int row = tid >> 3, c0 = ((tid & 7) + i * 8) * 8;
            const uint4 v = *(const uint4*)(qdec + (size_t)(n * 64 + row) * 1024 + h * 256 + c0);
            const f32x4 p0 = *(const f32x4*)(sP + c0), p1 = *(const f32x4*)(sP + c0 + 4);
            *(uint4*)(sA + row * 264 + c0) = make_uint4(pk2(bflo(v.x) * p0[0], bfhi(v.x) * p0[1]), pk2(bflo(v.y) * p0[2], bfhi(v.y) * p0[3]), pk2(bflo(v.z) * p1[0], bfhi(v.z) * p1[1]), pk2(bflo(v.w) * p1[2], bfhi(v.w) * p1[3])); }
        __syncthreads();
        f32x4 acc[4][4];
#pragma unroll
        for (int vt = 0; vt < 4; ++vt)
#pragma unroll
            for (int qt = 0; qt < 4; ++qt) acc[vt][qt] = (f32x4){0.f, 0.f, 0.f, 0.f};
        const bf16_t* stp = ST + ((size_t)h * 512 + wid * 64 + fr) * 256 + fq * 8;
#pragma unroll 2
        for (int ks = 0; ks < 8; ++ks) { bf16x8 bfr[4];
#pragma unroll
            for (int qt = 0; qt < 4; ++qt) bfr[qt] = *(const bf16x8*)(sA + (qt * 16 + fr) * 264 + ks * 32 + fq * 8);
#pragma unroll
            for (int vt = 0; vt < 4; ++vt) { const bf16x8 a = as_bf8(*(const uint4*)(stp + (size_t)vt * 16 * 256 + ks * 32));
#pragma unroll
                for (int qt = 0; qt < 4; ++qt) acc[vt][qt] = mfma16(a, bfr[qt], acc[vt][qt]); } }
        float* sSq = (float*)(smem + 34816);
        float rsq[4];
#pragma unroll
        for (int qt = 0; qt < 4; ++qt) { float sq = 0.f;
#pragma unroll
            for (int vt = 0; vt < 4; ++vt) { const f32x4 o = *(const f32x4*)(O + (size_t)(n * 64 + qt * 16 + fr) * 2048 + h * 512 + wid * 64 + vt * 16 + fq * 4) + acc[vt][qt]; acc[vt][qt] = o;
                sq += o[0] * o[0] + o[1] * o[1] + o[2] * o[2] + o[3] * o[3]; }
            sq += __shfl_xor(sq, 16); sq += __shfl_xor(sq, 32);
            if (fq == 0) sSq[(qt * 16 + fr) * 8 + wid] = sq; }
        __syncthreads();
#pragma unroll
        for (int qt = 0; qt < 4; ++qt) { const f32x4 s0 = *(const f32x4*)(sSq + (qt * 16 + fr) * 8), s1 = *(const f32x4*)(sSq + (qt * 16 + fr) * 8 + 4);
            rsq[qt] = rsqrtf((s0[0] + s0[1] + s0[2] + s0[3] + s1[0] + s1[1] + s1[2] + s1[3]) * (1.0f / 512.0f) + 1e-6f); }
        { const bf16_t* proj = (const bf16_t*)(p.ws + OFF_PROJ); bf16_t* A1 = (bf16_t*)(p.ws + OFF_A1); const float* onw = p.in[6];
#pragma unroll
          for (int vt = 0; vt < 4; ++vt) { const int vc = wid * 64 + vt * 16 + fq * 4; const f32x4 w4 = *(const f32x4*)(onw + vc);
#pragma unroll
              for (int qt = 0; qt < 4; ++qt) { const size_t t = (size_t)(n * 64 + qt * 16 + fr);
                  const uint2 gv = *(const uint2*)(proj + t * NPROJ + 4096 + h * 512 + vc);
                  const float g0 = bflo(gv.x), g1 = bfhi(gv.x), g2 = bflo(gv.y), g3 = bfhi(gv.y); const f32x4 o = acc[vt][qt] * rsq[qt];
                  *(uint2*)(A1 + t * 2048 + h * 512 + vc) = make_uint2(pk2(o[0] * w4[0] * g0 * __builtin_amdgcn_rcpf(1.0f + __expf(-g0)), o[1] * w4[1] * g1 * __builtin_amdgcn_rcpf(1.0f + __expf(-g1))),
                                                                       pk2(o[2] * w4[2] * g2 * __builtin_amdgcn_rcpf(1.0f + __expf(-g2)), o[3] * w4[3] * g3 * __builtin_amdgcn_rcpf(1.0f + __expf(-g3)))); } } }
        __syncthreads();
    }
    gla_onorm(p, wv, S_ * 2);
}

__device__ __forceinline__ void ffn_fix(const Params& p, int layer, int wv) {
    const bf16_t* halo = (const bf16_t*)(p.ws + OFF_HALO); bf16_t* act = (bf16_t*)(p.ws + OFF_BIG);
    const float* cw = p.in[18] + (size_t)layer * 3 * F2_; const float* cb = p.in[19] + (size_t)layer * F2_;
    const int gsz = gridDim.x * 512;
    for (int item = blockIdx.x * 512 + opaque_tid(wv); item < 704 * 512; item += gsz) { const int cgp = item % 704, rix = item / 704, g = rix >> 1, rr = rix & 1, f0 = cgp * 8;
        const uint4 z = make_uint4(0, 0, 0, 0);
#define HROW(gg, slot, part) (*(const uint4*)(halo + (size_t)(((gg) * 4 + (slot)) * 2 + (part)) * F_ + f0))
        const uint4 a0 = HROW(g, rr, 0), u0 = HROW(g, rr, 1);
        uint4 a1, u1, a2, u2;
        if (rr == 1) { a1 = HROW(g, 0, 0); u1 = HROW(g, 0, 1); if (g > 0) { a2 = HROW(g - 1, 3, 0); u2 = HROW(g - 1, 3, 1); } else { a2 = z; u2 = z; } }
        else if (g > 0) { a1 = HROW(g - 1, 3, 0); u1 = HROW(g - 1, 3, 1); a2 = HROW(g - 1, 2, 0); u2 = HROW(g - 1, 2, 1); }
        else { a1 = z; u1 = z; a2 = z; u2 = z; }
#undef HROW
        const u32 A2[4] = {a2.x, a2.y, a2.z, a2.w}, A1[4] = {a1.x, a1.y, a1.z, a1.w}, A0[4] = {a0.x, a0.y, a0.z, a0.w};
        const u32 U2[4] = {u2.x, u2.y, u2.z, u2.w}, U1[4] = {u1.x, u1.y, u1.z, u1.w}, U0[4] = {u0.x, u0.y, u0.z, u0.w};
        u32 ow[4];
#pragma unroll
        for (int e = 0; e < 4; ++e) { const int fl = f0 + 2 * e, fh = fl + 1;
            const float al = cb[fl] + cw[fl] * bflo(A2[e]) + cw[F2_ + fl] * bflo(A1[e]) + cw[2 * F2_ + fl] * bflo(A0[e]);
            const float ah = cb[fh] + cw[fh] * bfhi(A2[e]) + cw[F2_ + fh] * bfhi(A1[e]) + cw[2 * F2_ + fh] * bfhi(A0[e]);
            const float ul = cb[F_ + fl] + cw[F_ + fl] * bflo(U2[e]) + cw[F2_ + F_ + fl] * bflo(U1[e]) + cw[2 * F2_ + F_ + fl] * bflo(U0[e]);
            const float uh = cb[F_ + fh] + cw[F_ + fh] * bfhi(U2[e]) + cw[F2_ + F_ + fh] * bfhi(U1[e]) + cw[2 * F2_ + F_ + fh] * bfhi(U0[e]);
            ow[e] = pk2(al * __builtin_amdgcn_rcpf(1.0f + __expf(-al)) * ul, ah * __builtin_amdgcn_rcpf(1.0f + __expf(-ah)) * uh); }
        *(uint4*)(act + (size_t)(g * 64 + rr) * F_ + f0) = make_uint4(ow[0], ow[1], ow[2], ow[3]);
    }
}

__device__ __forceinline__ void moba_prep(const Params& p, unsigned char* smem, int wv) {
    const int tid = opaque_tid(wv), lane = tid & 63, wid = tid >> 6, l16 = lane & 15, sub = lane >> 4;
    const bf16_t* raw = (const bf16_t*)(p.ws + OFF_PROJ); bf16_t* qn = (bf16_t*)(p.ws + OFF_A3); bf16_t* kn = (bf16_t*)(p.ws + OFF_KN); bf16_t* vTm = (bf16_t*)(p.ws + OFF_VTM);
    float* kmean = (float*)(p.ws + OFF_KMEAN);
    bf16_t* sV = (bf16_t*)smem; float* sKm = (float*)(smem + 67584);
    { int* cnt = (int*)(p.ws + OFF_CNT); int* ctr = (int*)(p.ws + OFF_CTR);
      for (int e = blockIdx.x * 512 + tid; e < 1024; e += gridDim.x * 512) cnt[e] = 256;
      if (blockIdx.x == 0 && tid == 0) ctr[0] = 0; }
    float qw[8], kwt[8];
#pragma unroll
    for (int e = 0; e < 8; ++e) { qw[e] = p.in[13][l16 * 8 + e] * 0.08838834764831845f; kwt[e] = p.in[10][l16 * 8 + e]; }
    for (int u = blockIdx.x; u < 1024; u += gridDim.x) { const int h = u & 15, j = u >> 4;
#pragma unroll
        for (int it = 0; it < 8; ++it) { const int key = lane + 64 * (wid & 3), dg = it * 2 + (wid >> 2);
            const uint4 v = *(const uint4*)(raw + (size_t)(j * 256 + key) * NPROJ + 4096 + h * 128 + dg * 8);
            bf16_t* d = sV + (dg * 8) * 264 + key;
            d[0] = (bf16_t)(v.x & 0xffff); d[264] = (bf16_t)(v.x >> 16); d[528] = (bf16_t)(v.y & 0xffff); d[792] = (bf16_t)(v.y >> 16);
            d[1056] = (bf16_t)(v.z & 0xffff); d[1320] = (bf16_t)(v.z >> 16); d[1584] = (bf16_t)(v.w & 0xffff); d[1848] = (bf16_t)(v.w >> 16); }
        float ksum[8] = {0.f, 0.f, 0.f, 0.f, 0.f, 0.f, 0.f, 0.f};
#pragma unroll 2
        for (int it = 0; it < 8; ++it) { const size_t t = (size_t)(j * 256 + wid * 32 + it * 4 + sub);
            const uint4 qv = *(const uint4*)(raw + t * NPROJ + h * 128 + l16 * 8), kv = *(const uint4*)(raw + t * NPROJ + 2048 + h * 128 + l16 * 8);
            float q[8] = {bflo(qv.x), bfhi(qv.x), bflo(qv.y), bfhi(qv.y), bflo(qv.z), bfhi(qv.z), bflo(qv.w), bfhi(qv.w)};
            float k[8] = {bflo(kv.x), bfhi(kv.x), bflo(kv.y), bfhi(kv.y), bflo(kv.z), bfhi(kv.z), bflo(kv.w), bfhi(kv.w)};
            float sq = 0.f, sk = 0.f;
#pragma unroll
            for (int e = 0; e < 8; ++e) { sq += q[e] * q[e]; sk += k[e] * k[e]; }
#pragma unroll
            for (int o = 1; o < 16; o <<= 1) { sq += __shfl_xor(sq, o); sk += __shfl_xor(sk, o); }
            const float rq = rsqrtf(sq * (1.0f / 128.0f) + 1e-6f), rk = rsqrtf(sk * (1.0f / 128.0f) + 1e-6f);
#pragma unroll
            for (int e = 0; e < 8; ++e) { q[e] *= rq * qw[e]; k[e] *= rk * kwt[e]; ksum[e] += k[e]; }
            *(uint4*)(qn + ((size_t)h * S_ + t) * 128 + l16 * 8) = make_uint4(pk2(q[0], q[1]), pk2(q[2], q[3]), pk2(q[4], q[5]), pk2(q[6], q[7]));
            *(uint4*)(kn + ((size_t)h * S_ + t) * 128 + l16 * 8) = make_uint4(pk2(k[0], k[1]), pk2(k[2], k[3]), pk2(k[4], k[5]), pk2(k[6], k[7])); }
#pragma unroll
        for (int e = 0; e < 8; ++e) { ksum[e] += __shfl_xor(ksum[e], 16); ksum[e] += __shfl_xor(ksum[e], 32); }
        if (sub == 0) {
#pragma unroll
            for (int e = 0; e < 8; ++e) sKm[wid * 128 + l16 * 8 + e] = ksum[e]; }
        __syncthreads();
        if (tid < 128) { float s = 0.f;
#pragma unroll
            for (int w = 0; w < 8; ++w) s += sKm[w * 128 + tid];
            kmean[(size_t)(h * 64 + j) * 128 + tid] = s * (1.0f / 256.0f); }
#pragma unroll
        for (int it = 0; it < 8; ++it) { const int id = it * 512 + tid, d = id >> 5, part = id & 31;
            *(uint4*)(vTm + ((size_t)(h * 64 + j) * 128 + d) * 256 + part * 8) = *(const uint4*)(sV + d * 264 + part * 8); }
        __syncthreads();
    }
}

__device__ __forceinline__ void moba_gate(const Params& p, unsigned char* smem, int wv) {
    const int tid = opaque_tid(wv), lane = tid & 63, wid = tid >> 6, fr = lane & 15, fq = lane >> 4;
    const bf16_t* qn = (const bf16_t*)(p.ws + OFF_A3); const float* kmean = (const float*)(p.ws + OFF_KMEAN);
    int* cnt = (int*)(p.ws + OFF_CNT); bf16_t* lists = (bf16_t*)(p.ws + OFF_LISTS);
    bf16_t* sKh = (bf16_t*)smem; bf16_t* sKl = (bf16_t*)(smem + 17408);
    for (int u = blockIdx.x; u < 1024; u += gridDim.x) { const int h = u & 15, b = u >> 4, ntl = (b + 15) >> 4;
        for (int e = tid; e < ntl * 2048; e += 512) { const int n = e >> 7, d = e & 127; const float km = n < b ? kmean[(size_t)h * 8192 + e] : 0.f;
            const u32 hi = cvt_pk_bf16(km, km) & 0xffffu; const float rem = km - __uint_as_float(hi << 16);
            sKh[n * 136 + d] = (bf16_t)hi; sKl[n * 136 + d] = (bf16_t)(cvt_pk_bf16(rem, rem) & 0xffffu); }
        uint4 qf[2][4];
#pragma unroll
        for (int qt = 0; qt < 2; ++qt)
#pragma unroll
            for (int ks = 0; ks < 4; ++ks) qf[qt][ks] = *(const uint4*)(qn + ((size_t)h * S_ + b * 256 + wid * 32 + qt * 16 + fr) * 128 + ks * 32 + fq * 8);
        __syncthreads();
        float v0[2] = {-INFINITY, -INFINITY}, v1[2] = {-INFINITY, -INFINITY}, v2[2] = {-INFINITY, -INFINITY}; int i0[2] = {255, 255}, i1[2] = {255, 255}, i2[2] = {255, 255};
#define TOP_INS(z, g, n) do { if ((g) > v0[z]) { v2[z] = v1[z]; i2[z] = i1[z]; v1[z] = v0[z]; i1[z] = i0[z]; v0[z] = (g); i0[z] = (n); } else if ((g) > v1[z]) { v2[z] = v1[z]; i2[z] = i1[z]; v1[z] = (g); i1[z] = (n); } else if ((g) > v2[z]) { v2[z] = (g); i2[z] = (n); } } while (0)
        for (int nt = 0; nt < ntl; ++nt) { f32x4 acc[2] = {{0.f, 0.f, 0.f, 0.f}, {0.f, 0.f, 0.f, 0.f}};
#pragma unroll
            for (int ks = 0; ks < 4; ++ks) { const bf16x8 ah = *(const bf16x8*)(sKh + (nt * 16 + fr) * 136 + ks * 32 + fq * 8), al = *(const bf16x8*)(sKl + (nt * 16 + fr) * 136 + ks * 32 + fq * 8);
#pragma unroll
                for (int qt = 0; qt < 2; ++qt) { acc[qt] = mfma16(ah, as_bf8(qf[qt][ks]), acc[qt]); acc[qt] = mfma16(al, as_bf8(qf[qt][ks]), acc[qt]); } }
#pragma unroll
            for (int qt = 0; qt < 2; ++qt)
#pragma unroll
                for (int jj = 0; jj < 4; ++jj) { const int n = nt * 16 + fq * 4 + jj; const float g = n < b ? acc[qt][jj] : -INFINITY; TOP_INS(qt, g, n); } }
#pragma unroll
        for (int qt = 0; qt < 2; ++qt)
#pragma unroll
            for (int o = 16; o <= 32; o <<= 1) { const float pv0 = __shfl_xor(v0[qt], o), pv1 = __shfl_xor(v1[qt], o), pv2 = __shfl_xor(v2[qt], o);
                const int pi0 = __shfl_xor(i0[qt], o), pi1 = __shfl_xor(i1[qt], o), pi2 = __shfl_xor(i2[qt], o);
                TOP_INS(qt, pv0, pi0); TOP_INS(qt, pv1, pi1); TOP_INS(qt, pv2, pi2); }
#undef TOP_INS
        if (fq == 0) {
#pragma unroll
            for (int qt = 0; qt < 2; ++qt) { const int qi = wid * 32 + qt * 16 + fr, t = b * 256 + qi;
                lists[(size_t)(h * 64 + b) * 16384 + qi] = (bf16_t)((t << 2) | 3);
                if (i0[qt] != 255) { const int pos = atomicAdd(&cnt[h * 64 + i0[qt]], 1); lists[(size_t)(h * 64 + i0[qt]) * 16384 + pos] = (bf16_t)((t << 2) | 0); }
                if (i1[qt] != 255) { const int pos = atomicAdd(&cnt[h * 64 + i1[qt]], 1); lists[(size_t)(h * 64 + i1[qt]) * 16384 + pos] = (bf16_t)((t << 2) | 1); }
                if (i2[qt] != 255) { const int pos = atomicAdd(&cnt[h * 64 + i2[qt]], 1); lists[(size_t)(h * 64 + i2[qt]) * 16384 + pos] = (bf16_t)((t << 2) | 2); } } }
        __syncthreads();
    }
}
__device__ __forceinline__ void moba_attn(const Params& p, unsigned char* smem, int wv) {
    const int tid = opaque_tid(wv), lane = tid & 63, wid = tid >> 6, fr = lane & 15, fq = lane >> 4;
    const bf16_t* qn = (const bf16_t*)(p.ws + OFF_A3); const bf16_t* kn = (const bf16_t*)(p.ws + OFF_KN); const bf16_t* vTm = (const bf16_t*)(p.ws + OFF_VTM);
    const int* cntg = (const int*)(p.ws + OFF_CNT); int* ctr = (int*)(p.ws + OFF_CTR); const bf16_t* lists = (const bf16_t*)(p.ws + OFF_LISTS);
    bf16_t* opart = (bf16_t*)(p.ws + OFF_OPART); float2* ml = (float2*)(p.ws + OFF_ML);
    const float* rel_bias = p.in[15];
    bf16_t* sKs = (bf16_t*)smem; bf16_t* sVT = (bf16_t*)(smem + 69632); float* sBias = (float*)(smem + 137216); int* sU = (int*)(smem + 138240);
    for (;;) {
        if (tid == 0) *sU = atomicAdd(ctr, 1);
        __syncthreads();
        const int u = *sU;
        if (u >= 1024) break;
        const int j = u >> 4, h = u & 15;
        int tl = tid; asm volatile("" : "+v"(tl));
#pragma unroll
        for (int it = 0; it < 8; ++it) { const int id = it * 512 + tl;
            { const int key = id >> 4, dg = id & 15; *(uint4*)(sKs + key * 136 + dg * 8) = *(const uint4*)(kn + ((size_t)h * S_ + j * 256 + key) * 128 + dg * 8); }
            { const int d = id >> 5, part = id & 31, rem = d & 31, R = ((d >> 5) * 2 + ((rem >> 2) & 1)) * 16 + (rem >> 3) * 4 + (rem & 3); *(uint4*)(sVT + R * 264 + part * 8) = *(const uint4*)(vTm + ((size_t)(h * 64 + j) * 128 + d) * 256 + part * 8); } }
        if (tl < 129) { int bk = tl; if (tl >= 16) { bk = 16 + (int)(__logf((float)tl * 0.0625f) / 2.0794415416798357f * 16.0f); bk = bk > 31 ? 31 : bk; } sBias[tl] = rel_bias[bk * 16 + h]; }
        __syncthreads();
        const int cnt = cntg[h * 64 + j], npass = (cnt + 255) >> 8;
        const float c128 = sBias[128];
        const bf16_t* L = lists + (size_t)(h * 64 + j) * 16384;
        for (int pass = 0; pass < npass; ++pass) {
            const int base = pass * 256 + wid * 32;
            if (base >= cnt) continue;
            int tq[2], rq[2]; bool valid[2]; uint4 qf[2][4];
#pragma unroll
            for (int qt = 0; qt < 2; ++qt) { const int li = base + qt * 16 + fr; valid[qt] = li < cnt; const u32 e = L[valid[qt] ? li : base]; tq[qt] = (int)(e >> 2); rq[qt] = (int)(e & 3);
#pragma unroll
                for (int ks = 0; ks < 4; ++ks) qf[qt][ks] = *(const uint4*)(qn + ((size_t)h * S_ + tq[qt]) * 128 + ks * 32 + fq * 8); }
            float m[2] = {-1e30f, -1e30f}, l[2] = {0.f, 0.f};
            f32x4 oT[8][2];
#pragma unroll
            for (int dt = 0; dt < 8; ++dt) { oT[dt][0] = (f32x4){0.f, 0.f, 0.f, 0.f}; oT[dt][1] = (f32x4){0.f, 0.f, 0.f, 0.f}; }
            for (int kc = 0; kc < 4; ++kc) {
                if (pass == 0 && kc * 64 > wid * 32 + 31) continue;
                f32x4 sT[4][2];
                { const bf16_t* kp = sKs + (kc * 64 + fr) * 136 + fq * 8;
                  bf16x8 af[2][2];
                  af[0][0] = *(const bf16x8*)(kp); af[0][1] = *(const bf16x8*)(kp + 32);
#pragma unroll
                  for (int st2 = 0; st2 < 8; ++st2) { const int kt = st2 >> 1, kh = (st2 & 1) * 2;
                    if (st2 + 1 < 8) { const int nkt = (st2 + 1) >> 1, nkh = ((st2 + 1) & 1) * 2;
                        af[(st2 + 1) & 1][0] = *(const bf16x8*)(kp + nkt * 16 * 136 + nkh * 32); af[(st2 + 1) & 1][1] = *(const bf16x8*)(kp + nkt * 16 * 136 + (nkh + 1) * 32); }
                    if (kh == 0) { sT[kt][0] = (f32x4){0.f, 0.f, 0.f, 0.f}; sT[kt][1] = (f32x4){0.f, 0.f, 0.f, 0.f}; }
#pragma unroll
                    for (int k2 = 0; k2 < 2; ++k2) { sT[kt][0] = mfma16(af[st2 & 1][k2], as_bf8(qf[0][kh + k2]), sT[kt][0]); sT[kt][1] = mfma16(af[st2 & 1][k2], as_bf8(qf[1][kh + k2]), sT[kt][1]); } } }
                uint4 pb[2][2];
                const int kmax = j * 256 + kc * 64 + 63;
                const bool far = __all((tq[0] - kmax >= 128) && (tq[1] - kmax >= 128)) != 0;
#pragma unroll
                for (int qt = 0; qt < 2; ++qt) { float cm = -1e30f;
                    if (far) {
#pragma unroll
                        for (int kt = 0; kt < 4; ++kt)
#pragma unroll
                            for (int jj = 0; jj < 4; ++jj) { const float s = sT[kt][qt][jj] + c128; sT[kt][qt][jj] = s; cm = fmaxf(cm, s); }
                    } else {
#pragma unroll
                        for (int kh = 0; kh < 4; kh += 2) { float bv[2][4];
#pragma unroll
                            for (int kt = 0; kt < 2; ++kt)
#pragma unroll
                                for (int jj = 0; jj < 4; ++jj) { int dd = tq[qt] - (j * 256 + kc * 64 + (kh + kt) * 16 + fq * 4 + jj); dd = dd < 0 ? 0 : (dd > 128 ? 128 : dd); bv[kt][jj] = sBias[dd]; }
#pragma unroll
                            for (int kt = 0; kt < 2; ++kt)
#pragma unroll
                                for (int jj = 0; jj < 4; ++jj) { const int dd = tq[qt] - (j * 256 + kc * 64 + (kh + kt) * 16 + fq * 4 + jj);
                                    const float s = dd >= 0 ? sT[kh + kt][qt][jj] + bv[kt][jj] : -1e30f; sT[kh + kt][qt][jj] = s; cm = fmaxf(cm, s); } }
                    }
                    cm = fmaxf(cm, __shfl_xor(cm, 16)); cm = fmaxf(cm, __shfl_xor(cm, 32));
                    const float mn = fmaxf(m[qt], cm), alpha = __expf(m[qt] - mn); m[qt] = mn; float ls = l[qt] * alpha;
                    if (__any(alpha != 1.0f)) {
#pragma unroll
                    for (int dt = 0; dt < 8; ++dt) { oT[dt][qt][0] *= alpha; oT[dt][qt][1] *= alpha; oT[dt][qt][2] *= alpha; oT[dt][qt][3] *= alpha; } }
                    float pv[4][4];
#pragma unroll
                    for (int kt = 0; kt < 4; ++kt)
#pragma unroll
                        for (int jj = 0; jj < 4; ++jj) { pv[kt][jj] = __expf(sT[kt][qt][jj] - mn); ls += pv[kt][jj]; }
                    l[qt] = ls;
#pragma unroll
                    for (int kk = 0; kk < 2; ++kk) pb[qt][kk] = make_uint4(cvt_pk_bf16(pv[2 * kk][0], pv[2 * kk][1]), cvt_pk_bf16(pv[2 * kk][2], pv[2 * kk][3]), cvt_pk_bf16(pv[2 * kk + 1][0], pv[2 * kk + 1][1]), cvt_pk_bf16(pv[2 * kk + 1][2], pv[2 * kk + 1][3])); }
#pragma unroll
                for (int kk = 0; kk < 2; ++kk) { const bf16_t* vp = sVT + fr * 264 + kc * 64 + kk * 32 + fq * 4;
#pragma unroll
                    for (int g = 0; g < 2; ++g) { uint2 vlo[4], vhi[4];
#pragma unroll
                        for (int d4 = 0; d4 < 4; ++d4) { vlo[d4] = *(const uint2*)(vp + (g * 4 + d4) * 16 * 264); vhi[d4] = *(const uint2*)(vp + (g * 4 + d4) * 16 * 264 + 16); }
#pragma unroll
                        for (int d4 = 0; d4 < 4; ++d4) { const int dt = g * 4 + d4; const bf16x8 a = as_bf8(make_uint4(vlo[d4].x, vlo[d4].y, vhi[d4].x, vhi[d4].y));
                            oT[dt][0] = mfma16(a, as_bf8(pb[0][kk]), oT[dt][0]); oT[dt][1] = mfma16(a, as_bf8(pb[1][kk]), oT[dt][1]); } } }
            }
#pragma unroll
            for (int qt = 0; qt < 2; ++qt) { float lt = l[qt]; lt += __shfl_xor(lt, 16); lt += __shfl_xor(lt, 32); const float inv = 1.0f / lt;
                if (valid[qt]) { const size_t slot = (size_t)(h * 4 + rq[qt]) * S_ + tq[qt];
#pragma unroll
                    for (int d2 = 0; d2 < 4; ++d2) *(uint4*)(opart + slot * 128 + d2 * 32 + fq * 8) = make_uint4(cvt_pk_bf16(oT[2 * d2][qt][0] * inv, oT[2 * d2][qt][1] * inv), cvt_pk_bf16(oT[2 * d2][qt][2] * inv, oT[2 * d2][qt][3] * inv),
                                                                                                 cvt_pk_bf16(oT[2 * d2 + 1][qt][0] * inv, oT[2 * d2 + 1][qt][1] * inv), cvt_pk_bf16(oT[2 * d2 + 1][qt][2] * inv, oT[2 * d2 + 1][qt][3] * inv));
                    if (fq == 0) ml[slot] = make_float2(m[qt], lt); } }
        }
        __syncthreads();
    }
}

__device__ __forceinline__ void moba_combine(const Params& p, int wv) {
    const int tid = opaque_tid(wv), lane = tid & 63, wid = tid >> 6, sub = lane >> 4, l16 = lane & 15;
    const bf16_t* opart = (const bf16_t*)(p.ws + OFF_OPART); const float2* ml = (const float2*)(p.ws + OFF_ML); bf16_t* A5 = (bf16_t*)(p.ws + OFF_A3);
    const int nw = gridDim.x * 8;
    for (int g0 = blockIdx.x * 8 + wid; g0 < S_ * 4; g0 += 2 * nw) {
        float2 mlv[2][4]; uint4 xv[2][4]; int tt[2], hh[2], ns[2];
#pragma unroll
        for (int z = 0; z < 2; ++z) { int g = g0 + z * nw; g = g < S_ * 4 ? g : g0; const int t = g >> 2, h = (g & 3) * 4 + sub, own = t >> 8; tt[z] = t; hh[z] = h; ns[z] = own < 3 ? own : 3;
            const size_t slot0 = (size_t)(h * 4) * S_ + t;
#pragma unroll
            for (int r = 0; r < 4; ++r) { const bool ok = (r == 3) || (r < ns[z]);
                if (ok) { mlv[z][r] = ml[slot0 + (size_t)r * S_]; xv[z][r] = *(const uint4*)(opart + (slot0 + (size_t)r * S_) * 128 + l16 * 8); }
                else { mlv[z][r] = make_float2(-1e30f, 0.f); xv[z][r] = make_uint4(0, 0, 0, 0); } } }
#pragma unroll
        for (int z = 0; z < 2; ++z) { if (z == 1 && g0 + nw >= S_ * 4) break;
            float M = -1e30f;
#pragma unroll
            for (int r = 0; r < 4; ++r) M = fmaxf(M, mlv[z][r].x);
            float W = 0.f, o[8] = {0.f, 0.f, 0.f, 0.f, 0.f, 0.f, 0.f, 0.f};
#pragma unroll
            for (int r = 0; r < 4; ++r) { const bool ok = (r == 3) || (r < ns[z]); const float w = ok ? __expf(mlv[z][r].x - M) * mlv[z][r].y : 0.f; W += w;
                const u32 xs[4] = {xv[z][r].x, xv[z][r].y, xv[z][r].z, xv[z][r].w};
#pragma unroll
                for (int e = 0; e < 4; ++e) { o[2 * e] += w * bflo(xs[e]); o[2 * e + 1] += w * bfhi(xs[e]); } }
            const float inv = 1.0f / W;
            *(uint4*)(A5 + (size_t)tt[z] * 2048 + hh[z] * 128 + l16 * 8) = make_uint4(pk2(o[0] * inv, o[1] * inv), pk2(o[2] * inv, o[3] * inv), pk2(o[4] * inv, o[5] * inv), pk2(o[6] * inv, o[7] * inv)); }
    }
}

enum { K_NORM_GK = 0, K_NORM, K_GEMM_BF16, K_GEMM_RES, K_GLA_PREP, K_GLA_SCAN, K_ONORM, K_FIX, K_MOBA_PREP, K_GATE, K_ATTN, K_COMBINE, K_GEMM_ACT, K_SCANFIX };
constexpr int NSTEP = 21;

__global__ void __launch_bounds__(512, 2) fwd_kernel(Params p0) {
    extern __shared__ __attribute__((aligned(16))) unsigned char smem[];
    cg::grid_group grid = cg::this_grid();
    const int wv = __builtin_amdgcn_readfirstlane((int)(threadIdx.x >> 6));
    volatile LAS unsigned* xst = (volatile LAS unsigned*)(smem + LDS_BYTES - 16);
    if (threadIdx.x == 0) { xst[0] = 0u; xst[1] = 0u; }
    __syncthreads();
    const XcdBarrier xb = xcd_barrier_post((unsigned*)(p0.ws + OFF_BAR), xst);
    for (int step = 0; step < NSTEP; ++step) {
        size_t zz = 0; asm volatile("" : "+s"(zz));
        Params p = p0;
#pragma unroll
        for (int i = 0; i < 21; ++i) p.in[i] = p0.in[i] + zz;
        p.out = p0.out + zz; p.ws = p0.ws + zz; p.overlap = p0.overlap;
        bf16_t* W = (bf16_t*)(p.ws + OFF_W);
        float* out = p.out;
        int kind = 0, layer = 0; ConvJob c0 = {nullptr, nullptr, nullptr, 0, 0}, c1 = c0;
        Gemm g = {nullptr, nullptr, S_, 0, 0}; bf16_t* gO = nullptr; const float* gR = nullptr;
        switch (step) {
        case 0: kind = K_NORM_GK; c0 = {p.in[2], p.in[1], W, D_, NPROJ}; break;
        case 1: kind = K_GEMM_BF16; g = {(const bf16_t*)(p.ws + OFF_A3), W, S_, NPROJ, D_}; gO = (bf16_t*)(p.ws + OFF_PROJ); break;
        case 2: kind = K_GLA_PREP; if (!p.overlap) c0 = {p.in[7], nullptr, W, D_, D_}; break;
        case 3: kind = K_GLA_SCAN; break;
        case 4: kind = K_SCANFIX; break;
        case 5: kind = K_GEMM_RES; g = {(const bf16_t*)(p.ws + OFF_A1), p.overlap ? (const bf16_t*)(p.ws + OFF_X0) : W, S_, D_, D_}; gR = p.in[0]; break;
        case 6: kind = K_NORM; if (!p.overlap) c0 = {p.in[17], p.in[16], W, D_, F2_, 1}; break;
        case 7: kind = K_GEMM_ACT; layer = 0; g = {(const bf16_t*)(p.ws + OFF_A3), p.overlap ? (const bf16_t*)(p.ws + OFF_X1) : W, S_, F2_, D_}; break;
        case 8: kind = K_FIX; layer = 0; if (!p.overlap) c0 = {p.in[20], nullptr, W, F_, D_}; break;
        case 9: kind = K_GEMM_RES; g = {(const bf16_t*)(p.ws + OFF_BIG), p.overlap ? (const bf16_t*)(p.ws + OFF_X2) : W, S_, D_, F_}; gR = out; break;
        case 10: kind = K_NORM; if (!p.overlap) { c0 = {p.in[12], p.in[11], W, D_, D_}; c1 = {p.in[9], p.in[8], W + (size_t)D_ * D_, D_, 2 * D_}; } break;
        case 11: kind = K_GEMM_BF16; g = {(const bf16_t*)(p.ws + OFF_A3), p.overlap ? (const bf16_t*)(p.ws + OFF_X3) : W, S_, NPROJ, D_}; gO = (bf16_t*)(p.ws + OFF_PROJ); break;
        case 12: kind = K_MOBA_PREP; break;
        case 13: kind = K_GATE; break;
        case 14: kind = K_ATTN; break;
        case 15: kind = K_COMBINE; c0 = {p.in[14], nullptr, W, D_, D_}; break;
        case 16: kind = K_GEMM_RES; g = {(const bf16_t*)(p.ws + OFF_A3), W, S_, D_, D_}; gR = out; break;
        case 17: kind = K_NORM; c0 = {p.in[17] + (size_t)D_ * F2_, p.in[16] + D_, W, D_, F2_, 1}; break;
        case 18: kind = K_GEMM_ACT; layer = 1; g = {(const bf16_t*)(p.ws + OFF_A3), W, S_, F2_, D_}; break;
        case 19: kind = K_FIX; layer = 1; c0 = {p.in[20] + (size_t)F_ * D_, nullptr, W, F_, D_}; break;
        default: kind = K_GEMM_RES; g = {(const bf16_t*)(p.ws + OFF_BIG), W, S_, D_, F_}; gR = out; break;
        }
#ifdef PROBE_MASK
        const int reps = ((PROBE_MASK >> kind) & 1) ? 2 : 1;
#else
        const int reps = 1;
#endif
        for (int rep = 0; rep < reps; ++rep) {
        if (rep > 0) { grid.sync(); if (kind == K_ATTN && blockIdx.x == 0 && threadIdx.x == 0) *(int*)(p.ws + OFF_CTR) = 0; grid.sync(); }
        const bool last_rep = (rep + 1 == reps);
        conv_job(c0, (float*)smem, wv, (int)blockIdx.x, (int)gridDim.x);
        conv_job(c1, (float*)smem, wv, (int)blockIdx.x, (int)gridDim.x);
        switch (kind) {
        case K_NORM_GK: norm_rows<true>(p.in[0], (bf16_t*)(p.ws + OFF_A3), p.in[3], p.in[1], (float*)(p.ws + OFF_GK1), (float*)smem, wv); break;
        case K_NORM: norm_rows<false>(out, (bf16_t*)(p.ws + OFF_A3), nullptr, nullptr, nullptr, (float*)smem, wv); break;
        case K_GEMM_BF16: { StaticOrder so; so.init(g.M, g.N, (int)gridDim.x, (int)blockIdx.x); EpiBf16P e{gO, g.N}; gemm_phase<EpiBf16P, StaticOrder, false>((PG8_LAS unsigned char*)smem, g, so, e, nullptr, wv); } break;
        case K_GEMM_RES: { StaticOrder so; so.init(g.M, g.N, (int)gridDim.x, (int)blockIdx.x); EpiResF32 e{gR, out, D_}; gemm_phase<EpiResF32, StaticOrder, false>((PG8_LAS unsigned char*)smem, g, so, e, nullptr, wv); } break;
        case K_GLA_PREP: gla_prep(p, smem, wv); break;
        case K_GLA_SCAN: gla_scan(p, smem, wv, last_rep); break;
        case K_SCANFIX: gla_scanfix(p, smem, wv); break;
        case K_ONORM: gla_onorm(p, wv, S_ * 4); break;
        case K_FIX: ffn_fix(p, layer, wv); break;
        case K_GEMM_ACT: { StaticOrder so; so.init(g.M, g.N, (int)gridDim.x, (int)blockIdx.x);
            EpiConvAct e{(bf16_t*)(p.ws + OFF_BIG), (bf16_t*)(p.ws + OFF_HALO), p.in[18] + (size_t)layer * 3 * F2_, p.in[19] + (size_t)layer * F2_};
            gemm_phase<EpiConvAct, StaticOrder, false>((PG8_LAS unsigned char*)smem, g, so, e, nullptr, wv); } break;
        case K_MOBA_PREP: moba_prep(p, smem, wv); break;
        case K_GATE: moba_gate(p, smem, wv); break;
        case K_ATTN: moba_attn(p, smem, wv); break;
        default: moba_combine(p, wv); break;
        }
        }
        if (step + 1 < NSTEP) { if (p.overlap == 0x7fffffffffffffffLL) grid.sync(); else xcd_barrier(xb); }
    }
}

extern "C" void kernel_launch(void* const* d_in, const int* in_sizes, int n_in, void* d_out, int out_size, void* d_ws, size_t ws_size, hipStream_t stream) {
    static int grid_blocks = 0;
    if (grid_blocks == 0) {
        if (n_in != 21 || out_size != S_ * D_ || ws_size < WS_END2 + 16384) { fprintf(stderr, "kernel_launch: unexpected problem (n_in %d out %d ws %zu need %zu)\n", n_in, out_size, ws_size, (size_t)WS_END); grid_blocks = -1; return; }
        int dev = 0, cus = 0, per_cu = 0;
        hipGetDevice(&dev);
        hipDeviceGetAttribute(&cus, hipDeviceAttributeMultiprocessorCount, dev);
        if (hipFuncSetAttribute((const void*)fwd_kernel, hipFuncAttributeMaxDynamicSharedMemorySize, LDS_BYTES) != hipSuccess) { fprintf(stderr, "kernel_launch: hipFuncSetAttribute failed\n"); grid_blocks = -1; return; }
        if (hipOccupancyMaxActiveBlocksPerMultiprocessor(&per_cu, (const void*)fwd_kernel, 512, LDS_BYTES) != hipSuccess || per_cu < 1) { fprintf(stderr, "kernel_launch: occupancy query says %d\n", per_cu); per_cu = 1; (void)hipGetLastError(); }
        grid_blocks = cus * per_cu;
    }
    if (grid_blocks < 0) return;
    Params p{};
    for (int i = 0; i < 21; ++i) p.in[i] = (const float*)d_in[i];
    p.out = (float*)d_out; p.ws = (unsigned char*)d_ws; p.overlap = 0;
    if (hipMemsetAsync((char*)d_ws + OFF_BAR, 0, XCD_BAR_WORDS * 4, stream) != hipSuccess) { fprintf(stderr, "kernel_launch: memset failed\n"); return; }
    void* args[] = {&p};
    hipError_t e = hipLaunchCooperativeKernel((const void*)fwd_kernel, dim3(grid_blocks), dim3(512), args, LDS_BYTES, stream);
    if (e != hipSuccess) fprintf(stderr, "cooperative launch failed: %s (grid %d)\n", hipGetErrorString(e), grid_blocks);
}
```

```cpp
#include <hip/hip_runtime.h>
#include <hip/hip_cooperative_groups.h>
#include <cstdio>
namespace cg = cooperative_groups;
__device__ __forceinline__ int opaque_tid(int wv) { int t = __builtin_amdgcn_mbcnt_hi(~0u, __builtin_amdgcn_mbcnt_lo(~0u, 0u)); asm volatile("" : "+v"(t)); return wv * 64 + t; }
namespace pg8 {
#define PG8_LAS __attribute__((address_space(3)))
typedef unsigned short bf16_t;
typedef short bf16x8 __attribute__((ext_vector_type(8)));
typedef float f32x4 __attribute__((ext_vector_type(4)));
typedef unsigned u32x4 __attribute__((ext_vector_type(4)));
constexpr int BM = 256, BK = 64, HALF = 128, HTB = HALF * BK * 2  , STAGE_BYTES = 8 * HTB, NXCD = 8, WGM = 8;

__host__ __device__ __forceinline__ int lds_byte(int r, int c) { const int st = (r >> 4) * 2 + (c >> 5), rr = r & 15, cc = c & 31, ob = rr * 64 + cc * 2; return st * 1024 + (ob ^ (((ob >> 9) & 1) << 5)); }
__host__ __device__ __forceinline__ void stage_rc(int b, int& R, int& C) { const int st = b / 1024, sb = b % 1024, swz = sb ^ (((sb >> 9) & 1) << 5); R = (st >> 1) * 16 + swz / 64; C = (st & 1) * 32 + (swz % 64) / 2; }
__host__ __device__ __forceinline__ int perm32(int rho) { const int n = rho >> 4, i = rho & 15; return 8 * (i >> 2) + 4 * n + (i & 3); }

struct Unit { int pm, pn; };
struct Gemm { const bf16_t* A; const bf16_t* Bt; int M, N, K; };
struct StaticOrder {
    int nM, nN, nwg, G, c;
    __host__ __device__ void init(int M, int N, int G_, int c_) { nM = M / BM; nN = N / BM; nwg = nM * nN; G = G_; c = c_; }
    __host__ __device__ bool next(int i, Unit& u) const {
        const long L = (long)i * G + c; if (L >= nwg) return false;
        int wgid = (int)L; { const int q = nwg / NXCD, r = nwg % NXCD, xcd = wgid % NXCD, off = wgid / NXCD; wgid = (xcd < r ? xcd * (q + 1) : r * (q + 1) + (xcd - r) * q) + off; }
        const int nig = WGM * nN, gid = wgid / nig, fm = gid * WGM, gsz = (nM - fm) < WGM ? (nM - fm) : WGM;
        u.pm = fm + ((wgid % nig) % gsz); u.pn = (wgid % nig) / gsz; return true;
    }
    __device__ __forceinline__ void a_ready(const Unit&) const {}
    __device__ __forceinline__ void done(const Unit&) const {}
};
__device__ __forceinline__ unsigned cvt_pk_bf16(float lo, float hi) { unsigned r; asm volatile("v_cvt_pk_bf16_f32 %0, %1, %2" : "=v"(r) : "v"(lo), "v"(hi)); return r; }

template <class Epi, class Sched, bool STAMP = false>
__device__ __forceinline__ void gemm_phase(PG8_LAS unsigned char* lds, const Gemm g, const Sched& S, const Epi& E, unsigned long long* stamps, int wv) {
    const int tid = opaque_tid(wv), wid = __builtin_amdgcn_readfirstlane(tid >> 6), lane = tid & 63, wr = wid >> 2, wc = wid & 3, fr = lane & 15, fq = lane >> 4;
    const int K = g.K, nt = K / BK;
    int ts_lo = 0, ts_hi = 0, nts = 0; const unsigned long long rt_entry = STAMP ? (unsigned long long)wall_clock64() : 0ull;
#define PG8_STAMP() do { if (STAMP && wid == 0 && nts < 64) { const unsigned long long _c = (unsigned long long)clock64(); \
        ts_lo = (lane == nts) ? (int)(unsigned)_c : ts_lo; ts_hi = (lane == nts) ? (int)(unsigned)(_c >> 32) : ts_hi; ++nts; } } while (0)
    PG8_STAMP();
    unsigned voffA[2], voffB[2];
#pragma unroll
    for (int i = 0; i < 2; ++i) { int R, C; stage_rc(tid * 16 + i * 8192, R, C); const int Rb = Epi::PERM ? ((R & ~31) + perm32(R & 31)) : R;
        voffA[i] = (unsigned)(R * K + C) * 2u; voffB[i] = (unsigned)(Rb * K + C) * 2u; }
    const size_t kstep = (size_t)(BK * 2);
    const size_t hstep = (size_t)HALF * K * 2;
    const size_t tstep = 2 * hstep;
    const unsigned ldsw = (unsigned)wid * 1024u;
    const int aoff = lds_byte(wr * 64 + fr, fq * 8), boff = lds_byte(wc * 32 + fr, fq * 8);
#define PG8_SA(b, h) (((b) * 2 + (h)) * HTB)
#define PG8_SB(b, h) ((4 + (b) * 2 + (h)) * HTB)
#define PG8_STAGE(bufoff, gbase, voff) do { _Pragma("unroll") for (int _i = 0; _i < 2; ++_i) \
        __builtin_amdgcn_global_load_lds((const unsigned*)((const char*)(gbase) + (voff)[_i]), (PG8_LAS unsigned*)(lds + (bufoff) + ldsw + _i * 8192), 16, 0, 0); } while (0)
#define PG8_LDA(dst, b, h) do { _Pragma("unroll") for (int m = 0; m < 4; ++m) _Pragma("unroll") for (int k = 0; k < 2; ++k) dst[m][k] = *(const PG8_LAS bf16x8*)(lds + PG8_SA(b, h) + aoff + m * 2048 + k * 1024); } while (0)
#define PG8_LDB(dst, b, h) do { _Pragma("unroll") for (int n = 0; n < 2; ++n) _Pragma("unroll") for (int k = 0; k < 2; ++k) dst[n][k] = *(const PG8_LAS bf16x8*)(lds + PG8_SB(b, h) + boff + n * 2048 + k * 1024); } while (0)
#define PG8_MMA(ai, bj, At, Bt) do { __builtin_amdgcn_s_setprio(1); _Pragma("unroll") for (int m = 0; m < 4; ++m) _Pragma("unroll") for (int n = 0; n < 2; ++n) _Pragma("unroll") for (int k = 0; k < 2; ++k) \
        acc[ai][bj][m][n] = __builtin_amdgcn_mfma_f32_16x16x32_bf16(Bt[n][k], At[m][k], acc[ai][bj][m][n], 0, 0, 0); __builtin_amdgcn_s_setprio(0); } while (0)
#define PG8_WAIT_V(n) asm volatile("s_waitcnt vmcnt(" #n ")" ::: "memory")
#define PG8_WAIT_L(n) asm volatile("s_waitcnt lgkmcnt(" #n ")" ::: "memory")
#define PG8_BAR __builtin_amdgcn_s_barrier()
#define PG8_SCHED __builtin_amdgcn_sched_barrier(0)
    Unit cur, nxt; int ui = 0;
    if (!S.next(0, cur)) return;
    f32x4 acc[2][2][4][2];
#pragma unroll
    for (int a = 0; a < 2; ++a)
#pragma unroll
        for (int b = 0; b < 2; ++b)
#pragma unroll
            for (int m = 0; m < 4; ++m)
#pragma unroll
                for (int n = 0; n < 2; ++n) acc[a][b][m][n] = (f32x4){0.f, 0.f, 0.f, 0.f};
    bf16x8 At[4][2], B0[2][2], B1[2][2];
    const char* cA = (const char*)g.A + (size_t)cur.pm * tstep; const char* cB = (const char*)g.Bt + (size_t)cur.pn * tstep;
    S.a_ready(cur);
    PG8_STAGE(PG8_SB(0, 0), cB, voffB); PG8_STAGE(PG8_SA(0, 0), cA, voffA); PG8_STAGE(PG8_SB(0, 1), cB + hstep, voffB); PG8_STAGE(PG8_SA(0, 1), cA + hstep, voffA);
    if (wr == 1) PG8_BAR;
    PG8_WAIT_V(4); PG8_BAR;
    PG8_STAGE(PG8_SB(1, 0), cB + kstep, voffB); PG8_STAGE(PG8_SA(1, 0), cA + kstep, voffA); PG8_STAGE(PG8_SB(1, 1), cB + hstep + kstep, voffB);
    PG8_WAIT_V(6); PG8_BAR;
    PG8_STAMP();
    for (;;) {
        const bool has_next = S.next(ui + 1, nxt);
        const char* nA = has_next ? (const char*)g.A + (size_t)nxt.pm * tstep : cA; const char* nB = has_next ? (const char*)g.Bt + (size_t)nxt.pn * tstep : cB;
        for (int t = 0; t < nt; t += 2) {
            const bool last = (t == nt - 2);
            const char* a1 = cA + (size_t)(t + 1) * kstep;
            const char* a2 = last ? nA : cA + (size_t)(t + 2) * kstep; const char* b2 = last ? nB : cB + (size_t)(t + 2) * kstep;
            const char* a3 = a2 + kstep; const char* b3 = b2 + kstep;
            if (last && has_next) S.a_ready(nxt);
            PG8_LDB(B0, 0, 0); PG8_SCHED; PG8_LDA(At, 0, 0); PG8_STAGE(PG8_SA(1, 1), a1 + hstep, voffA);
            PG8_WAIT_L(8); PG8_BAR; PG8_WAIT_L(0); PG8_MMA(0, 0, At, B0); PG8_BAR; PG8_SCHED;
            PG8_LDB(B1, 0, 1); PG8_STAGE(PG8_SB(0, 0), b2, voffB);
            PG8_BAR; PG8_WAIT_L(0); PG8_MMA(0, 1, At, B1); PG8_BAR;
            PG8_LDA(At, 0, 1); PG8_STAGE(PG8_SA(0, 0), a2, voffA);
            PG8_BAR; PG8_WAIT_L(0); PG8_MMA(1, 0, At, B0); PG8_BAR; PG8_SCHED;
            PG8_STAGE(PG8_SB(0, 1), b2 + hstep, voffB);
            PG8_WAIT_V(6); PG8_BAR; PG8_MMA(1, 1, At, B1); PG8_BAR;
            PG8_LDB(B0, 1, 0); PG8_SCHED; PG8_LDA(At, 1, 0); PG8_STAGE(PG8_SA(0, 1), a2 + hstep, voffA);
            PG8_WAIT_L(8); PG8_BAR; PG8_WAIT_L(0); PG8_MMA(0, 0, At, B0); PG8_BAR; PG8_SCHED;
            PG8_LDB(B1, 1, 1); PG8_STAGE(PG8_SB(1, 0), b3, voffB);
            PG8_BAR; PG8_WAIT_L(0); PG8_MMA(0, 1, At, B1); PG8_BAR;
            PG8_LDA(At, 1, 1); PG8_STAGE(PG8_SA(1, 0), a3, voffA);
            PG8_BAR; PG8_WAIT_L(0); PG8_MMA(1, 0, At, B0); PG8_BAR; PG8_SCHED;
            PG8_STAGE(PG8_SB(1, 1), b3 + hstep, voffB);
            PG8_WAIT_V(6); PG8_BAR; PG8_MMA(1, 1, At, B1); PG8_BAR;
        }
        PG8_STAMP();
        if constexpr (!Epi::AFTER_DRAIN) { E(acc, cur, wr, wc, fr, fq); S.done(cur); }
        PG8_STAMP();
        if (!has_next) break;
#pragma unroll
        for (int a = 0; a < 2; ++a)
#pragma unroll
            for (int b = 0; b < 2; ++b)
#pragma unroll
                for (int m = 0; m < 4; ++m)
#pragma unroll
                    for (int n = 0; n < 2; ++n) acc[a][b][m][n] = (f32x4){0.f, 0.f, 0.f, 0.f};
        cur = nxt; cA = nA; cB = nB; ++ui;
    }
    PG8_WAIT_V(0);
    if (wr == 0) PG8_BAR;
    PG8_BAR;
    if constexpr (Epi::AFTER_DRAIN) { E.fused(acc, cur, wr, wc, fr, fq, lds, wid, lane); S.done(cur); }
    PG8_STAMP();
    if (STAMP && wid == 0) { stamps[lane] = lane < nts ? (((unsigned long long)(unsigned)ts_hi << 32) | (unsigned)ts_lo) : 0ull;
        if (lane == 62) stamps[62] = rt_entry; if (lane == 63) stamps[63] = (unsigned long long)wall_clock64(); }
#undef PG8_STAMP
#undef PG8_SA
#undef PG8_SB
#undef PG8_STAGE
#undef PG8_LDA
#undef PG8_LDB
#undef PG8_MMA
#undef PG8_WAIT_V
#undef PG8_WAIT_L
#undef PG8_BAR
#undef PG8_SCHED
}
}
#define XB_TMO      128
#define XB_XCNT(j)  (256  + 64 * (j))
#define XB_XSUB(j)  (1280 + 64 * (j))
#define XB_XGEN(j)  (2304 + 64 * (j))
#define XB_TOP      3328
#define XB_TOPGEN   3392
#define XCD_BAR_WORDS 3456
#define XB_SPIN_CAP (1u << 18)
#define LAS __attribute__((address_space(3)))

__device__ __forceinline__ unsigned xb_ld(unsigned* p)              { return __hip_atomic_load(p, __ATOMIC_RELAXED, __HIP_MEMORY_SCOPE_AGENT); }
__device__ __forceinline__ unsigned xb_add(unsigned* p, unsigned v) { return __hip_atomic_fetch_add(p, v, __ATOMIC_RELAXED, __HIP_MEMORY_SCOPE_AGENT); }
__device__ __forceinline__ unsigned xb_xcc_id() { return (unsigned)__builtin_amdgcn_s_getreg((3 << 11) | 20) & 0xFu; }
#define XB_SPIN(cond, bar) do { unsigned _sp = 0; while (cond) { __builtin_amdgcn_s_sleep(1); \
    if ((++_sp & 255u) == 0u) { if (xb_ld(&(bar)[XB_TMO])) break; if (_sp > XB_SPIN_CAP) { atomicAdd(&(bar)[XB_TMO], 1u); break; } } } } while (0)

struct XcdBarrier {
    unsigned* bar; unsigned x;
    volatile LAS unsigned* st;
};

__device__ __forceinline__ XcdBarrier xcd_barrier_post(unsigned* bar, volatile LAS unsigned* st) {
    XcdBarrier b; b.bar = bar; b.x = xb_xcc_id(); b.st = st;
    if (threadIdx.x == 0) (void)xb_add(&bar[XB_XCNT(b.x)], 1u);
    return b;
}
__device__ __forceinline__ void xcd_barrier_complete(unsigned* bar, unsigned x, unsigned& nloc, unsigned& nx) {
    const unsigned G = gridDim.x * gridDim.y * gridDim.z;
    unsigned sum, cnt, mine, sp = 0u;
    for (;;) {
        sum = 0u; cnt = 0u; mine = 0u;
#pragma unroll
        for (unsigned j = 0; j < 16; ++j) { const unsigned c = xb_ld(&bar[XB_XCNT(j)]); sum += c; cnt += (c > 0u) ? 1u : 0u; mine = (j == x) ? c : mine; }
        if (sum == G) break;
        __builtin_amdgcn_s_sleep(1);
        if ((++sp & 255u) == 0u) { if (xb_ld(&bar[XB_TMO])) break; if (sp > XB_SPIN_CAP) { atomicAdd(&bar[XB_TMO], 1u); break; } }
    }
    nloc = mine > 0u ? mine : 1u; nx = cnt > 0u ? cnt : 1u;
}

__device__ __forceinline__ void xcd_barrier(const XcdBarrier& b) {
    asm volatile("s_waitcnt vmcnt(0)" ::: "memory");
    __syncthreads();
    if (threadIdx.x == 0) {
        unsigned* bar = b.bar;
        __builtin_amdgcn_s_waitcnt(0);
        unsigned nloc = b.st[0], nx = b.st[1];
        if (nloc == 0u) { xcd_barrier_complete(bar, b.x, nloc, nx); b.st[0] = nloc; b.st[1] = nx; }
        const unsigned old = xb_add(&bar[XB_XSUB(b.x)], 1u);
        const unsigned gen = old / nloc;
        if (old + 1u == (gen + 1u) * nloc) {
            __builtin_amdgcn_fence(__ATOMIC_RELEASE, "agent");
            asm volatile("s_waitcnt vmcnt(0)" ::: "memory");
            const unsigned og = xb_add(&bar[XB_TOP], 1u);
            const unsigned tg = og / nx;
            if (og + 1u == (tg + 1u) * nx) xb_add(&bar[XB_TOPGEN], 1u);
            else XB_SPIN(xb_ld(&bar[XB_TOPGEN]) == tg, bar);
            __builtin_amdgcn_fence(__ATOMIC_ACQUIRE, "agent");
            xb_add(&bar[XB_XGEN(b.x)], 1u);
            asm volatile("s_waitcnt vmcnt(0)" ::: "memory");
        } else {
            XB_SPIN(xb_ld(&bar[XB_XGEN(b.x)]) == gen, bar);
            __builtin_amdgcn_fence(__ATOMIC_ACQUIRE, "agent");
            asm volatile("s_waitcnt vmcnt(0)" ::: "memory");
        }
    }
    __syncthreads();
}

using namespace pg8;
typedef unsigned int u32;
typedef float f32x2 __attribute__((ext_vector_type(2)));

constexpr int S_ = 16384, D_ = 2048, NPROJ = 6144, F_ = 5632, F2_ = 11264, NH = 16, DH = 128;
constexpr size_t OFF_W = 0;
constexpr size_t OFF_BIG = 46137344;
constexpr size_t OFF_A3 = OFF_BIG + 369098752;
constexpr size_t OFF_SM = OFF_A3 + 184549376;
constexpr size_t OFF_GK1 = OFF_SM;
constexpr size_t OFF_DECAY = OFF_GK1 + 1048576;
constexpr size_t OFF_KMEAN = OFF_DECAY + 1048576;
constexpr size_t OFF_SEL = OFF_KMEAN + 524288;
constexpr size_t OFF_CNT = OFF_SEL + 1048576;
constexpr size_t OFF_CTR = OFF_CNT + 4096;
constexpr size_t OFF_ML = OFF_CTR + 256;
constexpr size_t WS_END = OFF_ML + 8388608;
constexpr size_t OFF_X0 = WS_END;
constexpr size_t OFF_X1 = OFF_X0 + 8388608;
constexpr size_t OFF_X2 = OFF_X1 + 46137344;
constexpr size_t OFF_X3 = OFF_X2 + 23068672;
constexpr size_t WS_END2 = OFF_X3 + 25165824;
constexpr size_t OFF_POSIDX = OFF_X0;
constexpr size_t OFF_BASEG = OFF_SEL;
constexpr size_t OFF_ST = OFF_X0 + 4194304;
constexpr size_t OFF_ATT = OFF_X1;
constexpr size_t OFF_BAR = WS_END2;
constexpr size_t OFF_PROJ = OFF_BIG;
constexpr size_t OFF_QDEC = OFF_BIG + 201326592;
constexpr size_t OFF_KENDT = OFF_QDEC + 33554432;
constexpr size_t OFF_VT = OFF_KENDT + 33554432;
constexpr size_t OFF_A1 = OFF_VT;
constexpr size_t OFF_VTM = OFF_BIG + 268435456;
constexpr size_t OFF_LISTS = OFF_BIG + 335544320;
constexpr size_t OFF_OPART = OFF_BIG;
constexpr size_t OFF_HALO = OFF_BIG + 184549376;
constexpr size_t OFF_KN = OFF_A3 + 67108864;
constexpr int LDS_BYTES = 163840;

struct Params { const float* in[21]; float* out; unsigned char* ws; long long overlap; };

__device__ __forceinline__ float bf2f(u32 b) { return __uint_as_float(b << 16); }
__device__ __forceinline__ float bflo(u32 w) { return __uint_as_float(w << 16); }
__device__ __forceinline__ float bfhi(u32 w) { return __uint_as_float(w & 0xffff0000u); }
__device__ __forceinline__ bf16_t f2bf(float f) { u32 u = __float_as_uint(f); u += 0x7FFFu + ((u >> 16) & 1u); return (bf16_t)(u >> 16); }
__device__ __forceinline__ u32 pk2(float lo, float hi) { return (u32)f2bf(lo) | ((u32)f2bf(hi) << 16); }
__device__ __forceinline__ float wave_sum(float v) {
#pragma unroll
    for (int o = 32; o; o >>= 1) v += __shfl_xor(v, o);
    return v;
}
__device__ __forceinline__ bf16x8 as_bf8(uint4 v) { return __builtin_bit_cast(bf16x8, v); }
__device__ __forceinline__ f32x4 mfma16(bf16x8 a, bf16x8 b, f32x4 c) { return __builtin_amdgcn_mfma_f32_16x16x32_bf16(a, b, c, 0, 0, 0); }

struct EpiBf16P {
    static constexpr bool PERM = true, AFTER_DRAIN = false;
    bf16_t* O; int ldc;
    __device__ __forceinline__ void operator()(const f32x4 (&acc)[2][2][4][2], const Unit& u, int wr, int wc, int fr, int fq) const {
        const int row0 = u.pm * BM + wr * 64 + fr; const int col0 = u.pn * BM + wc * 32 + 8 * fq;
#pragma unroll
        for (int ai = 0; ai < 2; ++ai)
#pragma unroll
            for (int m = 0; m < 4; ++m) { bf16_t* rowp = O + (size_t)(row0 + ai * HALF + m * 16) * ldc + col0;
#pragma unroll
                for (int bj = 0; bj < 2; ++bj) { const f32x4 v0 = acc[ai][bj][m][0], v1 = acc[ai][bj][m][1];
                    uint4 w; w.x = cvt_pk_bf16(v0[0], v0[1]); w.y = cvt_pk_bf16(v0[2], v0[3]); w.z = cvt_pk_bf16(v1[0], v1[1]); w.w = cvt_pk_bf16(v1[2], v1[3]);
                    *(uint4*)(rowp + bj * HALF) = w; } }
    }
};
struct EpiResF32 {
    static constexpr bool PERM = false, AFTER_DRAIN = false;
    const float* R; float* C; int ldc;
    __device__ __forceinline__ void operator()(const f32x4 (&acc)[2][2][4][2], const Unit& u, int wr, int wc, int fr, int fq) const {
        const int row0 = u.pm * BM + wr * 64 + fr, col0 = u.pn * BM + wc * 32 + 4 * fq;
#pragma unroll
        for (int ai = 0; ai < 2; ++ai)
#pragma unroll
            for (int m = 0; m < 4; ++m) { const size_t ro = (size_t)(row0 + ai * HALF + m * 16) * ldc + col0;
#pragma unroll
                for (int bj = 0; bj < 2; ++bj)
#pragma unroll
                    for (int n = 0; n < 2; ++n) { const f32x4 r = *(const f32x4*)(R + ro + bj * HALF + n * 16); *(f32x4*)(C + ro + bj * HALF + n * 16) = acc[ai][bj][m][n] + r; } }
    }
};


template <int CTRL> __device__ __forceinline__ float dppz(float x) { return __builtin_bit_cast(float, __builtin_amdgcn_update_dpp(0, __builtin_bit_cast(int, x), CTRL, 0xf, 0xf, true)); }
struct EpiConvAct {
    static constexpr bool PERM = true, AFTER_DRAIN = false;
    bf16_t* act; bf16_t* halo; const float* cw; const float* cb;
    __device__ __forceinline__ void operator()(const f32x4 (&acc)[2][2][4][2], const Unit& u, int wr, int wc, int fr, int fq) const {
        const int fcol = u.pn * 128 + wc * 32 + 8 * fq;
        uint2 outp[2][4][2];
#pragma unroll
        for (int n = 0; n < 2; ++n) { const int f = fcol + 4 * n;
            const f32x4 wa0 = *(const f32x4*)(cw + f), wa1 = *(const f32x4*)(cw + F2_ + f), wa2 = *(const f32x4*)(cw + 2 * F2_ + f), ba = *(const f32x4*)(cb + f);
            const f32x4 wu0 = *(const f32x4*)(cw + F_ + f), wu1 = *(const f32x4*)(cw + F2_ + F_ + f), wu2 = *(const f32x4*)(cw + 2 * F2_ + F_ + f), bu = *(const f32x4*)(cb + F_ + f);
#pragma unroll
            for (int ai = 0; ai < 2; ++ai) { const int g = u.pm * 4 + ai * 2 + wr;
#pragma unroll
                for (int m = 0; m < 4; ++m) { const f32x4 xa = acc[ai][0][m][n], xu = acc[ai][1][m][n];
                    const f32x4 pa = m > 0 ? acc[ai][0][m > 0 ? m - 1 : 0][n] : (f32x4){0.f, 0.f, 0.f, 0.f}, pu = m > 0 ? acc[ai][1][m > 0 ? m - 1 : 0][n] : (f32x4){0.f, 0.f, 0.f, 0.f};
                    float o[4];
#pragma unroll
                    for (int jj = 0; jj < 4; ++jj) {
                        const float a1 = dppz<0x111>(xa[jj]) + dppz<0x10F>(pa[jj]), a2 = dppz<0x112>(xa[jj]) + dppz<0x10E>(pa[jj]);
                        const float u1 = dppz<0x111>(xu[jj]) + dppz<0x10F>(pu[jj]), u2 = dppz<0x112>(xu[jj]) + dppz<0x10E>(pu[jj]);
                        const float A = ba[jj] + wa0[jj] * a2 + wa1[jj] * a1 + wa2[jj] * xa[jj], U = bu[jj] + wu0[jj] * u2 + wu1[jj] * u1 + wu2[jj] * xu[jj];
                        o[jj] = A * __builtin_amdgcn_rcpf(1.0f + __expf(-A)) * U; }
                    outp[ai][m][n] = make_uint2(cvt_pk_bf16(o[0], o[1]), cvt_pk_bf16(o[2], o[3]));
                    if ((m == 0 && fr < 2) || (m == 3 && fr >= 14)) { const int slot = (m == 0) ? fr : fr - 12;
                        bf16_t* hp = halo + (size_t)((g * 4 + slot) * 2) * F_ + f;
                        *(uint2*)hp = make_uint2(cvt_pk_bf16(xa[0], xa[1]), cvt_pk_bf16(xa[2], xa[3]));
                        *(uint2*)(hp + F_) = make_uint2(cvt_pk_bf16(xu[0], xu[1]), cvt_pk_bf16(xu[2], xu[3])); } } } }
        const int row0 = u.pm * BM + wr * 64 + fr;
#pragma unroll
        for (int ai = 0; ai < 2; ++ai)
#pragma unroll
            for (int m = 0; m < 4; ++m) if (!(m == 0 && fr < 2))
                *(uint4*)(act + (size_t)(row0 + ai * HALF + m * 16) * F_ + fcol) = make_uint4(outp[ai][m][0].x, outp[ai][m][0].y, outp[ai][m][1].x, outp[ai][m][1].y);
    }
};

struct ConvJob { const float* W; const float* gain; bf16_t* dst; int K, N; int perm; };
__device__ __forceinline__ void conv_job(const ConvJob j, float* lds, int wv, int worker, int nworkers) {
    if (!j.W) return;
    const int tid = opaque_tid(wv);
    const int ntn = j.N >> 7, nt = ntn * (j.K >> 6);
    for (int tile = worker * 2; tile < nt; tile += nworkers * 2) {
        const int k0 = (tile / ntn) << 6, n0 = (tile % ntn) << 7;
        float4 v[2][4];
#pragma unroll
        for (int hh = 0; hh < 2; ++hh)
#pragma unroll
            for (int i = 0; i < 4; ++i) { const int idx = tid + i * 512, kk = idx >> 5, n4 = idx & 31;
                v[hh][i] = *(const float4*)(j.W + (size_t)(k0 + kk) * j.N + n0 + hh * 128 + n4 * 4); }
        if (j.gain) {
#pragma unroll
            for (int i = 0; i < 4; ++i) { const float g = j.gain[k0 + ((tid + i * 512) >> 5)];
#pragma unroll
                for (int hh = 0; hh < 2; ++hh) { v[hh][i].x *= g; v[hh][i].y *= g; v[hh][i].z *= g; v[hh][i].w *= g; } } }
        __syncthreads();
#pragma unroll
        for (int hh = 0; hh < 2; ++hh)
#pragma unroll
            for (int i = 0; i < 4; ++i) { const int idx = tid + i * 512, kk = idx >> 5, n4 = idx & 31; float* d = lds + hh * 8320 + (n4 * 4) * 65 + kk;
                d[0] = v[hh][i].x; d[65] = v[hh][i].y; d[130] = v[hh][i].z; d[195] = v[hh][i].w; }
        __syncthreads();
#pragma unroll
        for (int hh = 0; hh < 2; ++hh)
#pragma unroll
            for (int i = 0; i < 2; ++i) { const int idx = tid + i * 512, n = idx >> 3, kg = idx & 7; const float* s = lds + hh * 8320 + n * 65 + kg * 8;
                uint4 w; w.x = pk2(s[0], s[1]); w.y = pk2(s[2], s[3]); w.z = pk2(s[4], s[5]); w.w = pk2(s[6], s[7]);
                const int nb = n0 + hh * 128, rb = j.perm ? (nb < F_ ? (nb >> 7) * 256 : ((nb - F_) >> 7) * 256 + 128) : nb;
                *(uint4*)(j.dst + (size_t)(rb + n) * j.K + k0 + kg * 8) = w; }
    }
    __syncthreads();
}

template <bool GK>
__device__ __forceinline__ void norm_rows(const float* X, bf16_t* Y, const float* w1, const float* g, float* gk1, float* lds, int wv) {
    const int tid = opaque_tid(wv), lane = tid & 63, wid = tid >> 6;
    if (GK) { for (int e = tid; e < 32768; e += 512) { const int k = e >> 4, r = e & 15; lds[r * 2048 + k] = w1[e] * g[k]; } __syncthreads(); }
    const int nw = gridDim.x * 8;
    for (int t = blockIdx.x * 8 + wid; t < S_; t += nw) {
        float4 x[8]; float ss = 0.f;
#pragma unroll
        for (int i = 0; i < 8; ++i) { x[i] = *(const float4*)(X + (size_t)t * D_ + (i * 64 + lane) * 4); ss += x[i].x * x[i].x + x[i].y * x[i].y + x[i].z * x[i].z + x[i].w * x[i].w; }
        ss = wave_sum(ss);
        const float rinv = rsqrtf(ss * (1.0f / D_) + 1e-6f);
#pragma unroll
        for (int i = 0; i < 8; ++i) { uint2 w; w.x = pk2(x[i].x * rinv, x[i].y * rinv); w.y = pk2(x[i].z * rinv, x[i].w * rinv); *(uint2*)(Y + (size_t)t * D_ + (i * 64 + lane) * 4) = w; }
        if (GK) {
            float a[16];
#pragma unroll
            for (int r = 0; r < 16; ++r) { if ((r & 1) == 0) asm volatile("" ::: "memory"); float acc = 0.f;
#pragma unroll
                for (int i = 0; i < 8; ++i) { const float4 w = *(const float4*)(lds + r * 2048 + (i * 64 + lane) * 4); acc += x[i].x * w.x + x[i].y * w.y + x[i].z * w.z + x[i].w * w.w; }
                a[r] = acc; }
            const bool b5 = (lane & 32) != 0, b4 = (lane & 16) != 0, b3 = (lane & 8) != 0, b2 = (lane & 4) != 0;
            float s8[8], s4[4], s2[2];
#pragma unroll
            for (int i = 0; i < 8; ++i) { const float snd = b5 ? a[i] : a[i + 8], kp = b5 ? a[i + 8] : a[i]; s8[i] = kp + __shfl_xor(snd, 32); }
#pragma unroll
            for (int i = 0; i < 4; ++i) { const float snd = b4 ? s8[i] : s8[i + 4], kp = b4 ? s8[i + 4] : s8[i]; s4[i] = kp + __shfl_xor(snd, 16); }
#pragma unroll
            for (int i = 0; i < 2; ++i) { const float snd = b3 ? s4[i] : s4[i + 2], kp = b3 ? s4[i + 2] : s4[i]; s2[i] = kp + __shfl_xor(snd, 8); }
            float s1; { const float snd = b2 ? s2[0] : s2[1], kp = b2 ? s2[1] : s2[0]; s1 = kp + __shfl_xor(snd, 4); }
            s1 += __shfl_xor(s1, 2); s1 += __shfl_xor(s1, 1);
            if ((lane & 3) == 0) gk1[(size_t)t * 16 + (lane >> 2)] = s1 * rinv;
        }
    }
    if (GK) __syncthreads();
}

__device__ __forceinline__ void gla_prep(const Params& p, unsigned char* smem, int wv) {
    const int tid = opaque_tid(wv), lane = tid & 63, wid = tid >> 6, fr = lane & 15, fq = lane >> 4;
    const bf16_t* proj = (const bf16_t*)(p.ws + OFF_PROJ);
    bf16_t* qdec = (bf16_t*)(p.ws + OFF_QDEC); bf16_t* kendT = (bf16_t*)(p.ws + OFF_KENDT); bf16_t* vTg = (bf16_t*)(p.ws + OFF_VT);
    const float* gk1 = (const float*)(p.ws + OFF_GK1); float* decay = (float*)(p.ws + OFF_DECAY);
    const float* gk_w2 = p.in[4]; const float* gk_b = p.in[5];
    bf16_t* sVT = (bf16_t*)smem; bf16_t* sQ = (bf16_t*)(smem + 73728); bf16_t* sK = (bf16_t*)(smem + 107520); bf16_t* sAt = (bf16_t*)(smem + 141312);
    float* sTot = (float*)(smem + 150528); float* sG = (float*)(smem + 152576);
    for (int u = blockIdx.x; u < 1024; u += gridDim.x) {
        const int h = u & 3, n = u >> 2, t0 = n * 64;
        for (int e = tid; e < 1024; e += 512) { const int s = e >> 4, r = e & 15; sG[(s >> 1) * 32 + r * 2 + (s & 1)] = gk1[(size_t)t0 * 16 + e]; }
#pragma unroll
        for (int i = 0; i < 4; ++i) { const int id = tid + i * 512, row = id >> 5, piece = id & 31;
            const bf16_t* src = proj + (size_t)(t0 + row) * NPROJ + h * 256 + piece * 8;
            *(uint4*)(sQ + row * 264 + piece * 8) = *(const uint4*)src; *(uint4*)(sK + row * 264 + piece * 8) = *(const uint4*)(src + 1024); }
        __syncthreads();
        const int c = tid & 255, half = tid >> 8;
        float bl[32];
        { float w2c[16];
#pragma unroll
          for (int r = 0; r < 16; ++r) w2c[r] = gk_w2[r * 1024 + h * 256 + c];
          const float bias = gk_b[h * 256 + c]; float run = 0.f;
#pragma unroll
          for (int i = 0; i < 32; i += 2) { if ((i & 3) == 0) asm volatile("" ::: "memory");
              const f32x4* gr = (const f32x4*)(sG + (half * 16 + (i >> 1)) * 32); f32x2 gv = {bias, bias};
#pragma unroll
              for (int r = 0; r < 16; r += 2) { const f32x4 g4 = gr[r >> 1]; gv += (f32x2){g4[0], g4[1]} * w2c[r]; gv += (f32x2){g4[2], g4[3]} * w2c[r + 1]; }
              run += (fminf(gv[0], 0.f) - __logf(1.0f + __expf(-fabsf(gv[0])))) * 0.0625f; bl[i] = run;
              run += (fminf(gv[1], 0.f) - __logf(1.0f + __expf(-fabsf(gv[1])))) * 0.0625f; bl[i + 1] = run; }
          sTot[half * 256 + c] = run; }
        __syncthreads();
        const float blast = sTot[c] + sTot[256 + c], boff = half ? sTot[c] : 0.f, eblast = __expf(blast);
        if (half == 0) decay[(size_t)(h * 256 + n) * 256 + c] = eblast;
#pragma unroll
        for (int i = 0; i < 32; ++i) { const int s = half * 32 + i; const float eb = __expf(bl[i] + boff);
            const float qv = bf2f(sQ[s * 264 + c]), kv = bf2f(sK[s * 264 + c]);
            const u32 pkd = cvt_pk_bf16(qv * 0.0625f * eb, kv * __builtin_amdgcn_rcpf(eb)); sQ[s * 264 + c] = (bf16_t)(pkd & 0xffffu); sK[s * 264 + c] = (bf16_t)(pkd >> 16); }
        __syncthreads();
#pragma unroll
        for (int i = 0; i < 4; ++i) { const int id = tid + i * 512, row = id >> 5, piece = id & 31;
            *(uint4*)(qdec + (size_t)(t0 + row) * 1024 + h * 256 + piece * 8) = *(const uint4*)(sQ + row * 264 + piece * 8); }
#pragma unroll
        for (int tt = 0; tt < 2; ++tt) { const int id = wid + tt * 8, st = id >> 2, qt = id & 3;
            f32x4 acc = {0.f, 0.f, 0.f, 0.f};
            if (st <= qt) {
#pragma unroll
                for (int ks = 0; ks < 8; ++ks) { const bf16x8 a = *(const bf16x8*)(sK + (st * 16 + fr) * 264 + ks * 32 + fq * 8); const bf16x8 b = *(const bf16x8*)(sQ + (qt * 16 + fr) * 264 + ks * 32 + fq * 8); acc = mfma16(a, b, acc); } }
            const int q = qt * 16 + fr, s0 = st * 16 + fq * 4;
            uint2 w; w.x = pk2(s0 <= q ? acc[0] : 0.f, s0 + 1 <= q ? acc[1] : 0.f); w.y = pk2(s0 + 2 <= q ? acc[2] : 0.f, s0 + 3 <= q ? acc[3] : 0.f);
            *(uint2*)(sAt + q * 72 + s0) = w; }
        __syncthreads();
        { u32 kp[16];
#pragma unroll
          for (int i = 0; i < 32; i += 2) kp[i >> 1] = cvt_pk_bf16(bf2f(sK[(half * 32 + i) * 264 + c]) * eblast, bf2f(sK[(half * 32 + i + 1) * 264 + c]) * eblast);
          uint4* kdst = (uint4*)(kendT + ((size_t)(h * 256 + n) * 256 + c) * 64 + half * 32);
#pragma unroll
          for (int i = 0; i < 4; ++i) kdst[i] = make_uint4(kp[4 * i], kp[4 * i + 1], kp[4 * i + 2], kp[4 * i + 3]); }
        { bf16_t* attnG = (bf16_t*)(p.ws + OFF_ATT) + ((size_t)(h * 256 + n) * 64 + (tid >> 3)) * 64 + (tid & 7) * 8;
          *(uint4*)attnG = *(const uint4*)(sAt + (tid >> 3) * 72 + (tid & 7) * 8); }
        __syncthreads();
    }
}
__device__ __forceinline__ void gla_scan(const Params& p, unsigned char* smem, int wv, bool do_store) {
    const int tid = opaque_tid(wv), lane = tid & 63, wid = tid >> 6, fr = lane & 15, fq = lane >> 4;
    const bf16_t* qdec = (const bf16_t*)(p.ws + OFF_QDEC); const bf16_t* kendT = (const bf16_t*)(p.ws + OFF_KENDT); const bf16_t* vTg = (const bf16_t*)(p.ws + OFF_VT);
    float* O = (float*)(p.ws + OFF_A3); const float* decay = (const float*)(p.ws + OFF_DECAY);
    unsigned char* sQc = smem;
    unsigned char* sKc = smem + 33792;
    unsigned char* sVc = smem + 70656;
    float* sDf = (float*)(smem + 72960);
    unsigned char* sAc = smem + 73984;
    float* sRed = (float*)(smem + 83200);
    for (int u0 = blockIdx.x; u0 < 256; u0 += gridDim.x) {
        const int xcd = u0 & 7, idx = (u0 >> 3) & 15, seg = u0 >> 7, nbeg = seg * 128, nlast = nbeg + 127;
        const int h = xcd >> 1, v0 = ((xcd & 1) * 16 + idx) * 16, kw = wid * 32;
        const bf16_t* qg = qdec + (size_t)(tid >> 3) * 1024 + h * 256 + (tid & 7) * 8;
        const bf16_t* kg = kendT + (size_t)h * 4194304 + (size_t)tid * 8;
        const bf16_t* vg = (const bf16_t*)(p.ws + OFF_PROJ) + (size_t)((tid & 127) >> 1) * NPROJ + 2048 + h * 512 + v0 + (tid & 1) * 8;
        const float* dg = decay + (size_t)h * 65536 + (tid & 63) * 4;
        unsigned char* qs = sQc + (tid >> 3) * 528 + (tid & 7) * 16;
        unsigned char* ks_ = sKc + (tid >> 3) * 144 + (tid & 7) * 16;
        unsigned short* vs_ = (unsigned short*)(sVc + ((tid & 1) * 8) * 144) + ((tid & 127) >> 1);
        unsigned char* as_ = sAc + (tid >> 3) * 144 + (tid & 7) * 16;
        const bf16_t* ag = (const bf16_t*)(p.ws + OFF_ATT) + (size_t)h * 1048576 + (size_t)tid * 8;
        const unsigned char* ard = sAc + ((wid & 3) * 16 + fr) * 144 + (wid >> 2) * 64 + fq * 16;
        const int e2 = tid * 2, oq = e2 >> 4, ov = e2 & 15;
        float* ob = O + (size_t)oq * 2048 + h * 512 + v0 + ov;
        const unsigned char* qrd = sQc + fr * 528 + (kw + fq * 4) * 2;
        const unsigned char* krd = sKc + (kw + fr) * 144 + fq * 16;
        const unsigned char* vrd = sVc + fr * 144 + fq * 16;
        const float* drd = sDf + kw + fq * 4;
        u32x4 bq[4][4], bk[4][4], bv[4], bd[4], ba[4];
        f32x4 st[2] = {{0.f, 0.f, 0.f, 0.f}, {0.f, 0.f, 0.f, 0.f}};
#define SCAN_LB1(s, n, i) bq[s][i] = *(const u32x4*)(qg + (size_t)(n) * 65536 + (i) * 64); bk[s][i] = *(const u32x4*)(kg + (size_t)(n) * 16384 + (i) * 4096);
#define SCAN_LOAD(s, n) do { SCAN_LB1(s, n, 0) SCAN_LB1(s, n, 1) SCAN_LB1(s, n, 2) SCAN_LB1(s, n, 3) \
            bv[s] = *(const u32x4*)(vg + (size_t)(n) * 393216); bd[s] = *(const u32x4*)(dg + (size_t)(n) * 256); ba[s] = *(const u32x4*)(ag + (size_t)(n) * 4096); } while (0)
#define SCAN_ST1(s, i) *(u32x4*)(qs + (i) * 128) = bq[s][i]; *(u32x4*)(ks_ + (i) * 9216) = bk[s][i];
#define SCAN_STAGE(s) do { SCAN_ST1(s, 0) SCAN_ST1(s, 1) SCAN_ST1(s, 2) SCAN_ST1(s, 3) if (tid < 128) { vs_[0] = (unsigned short)bv[s][0]; vs_[72] = (unsigned short)(bv[s][0] >> 16); vs_[144] = (unsigned short)bv[s][1]; vs_[216] = (unsigned short)(bv[s][1] >> 16); vs_[288] = (unsigned short)bv[s][2]; vs_[360] = (unsigned short)(bv[s][2] >> 16); vs_[432] = (unsigned short)bv[s][3]; vs_[504] = (unsigned short)(bv[s][3] >> 16); } if (tid < 64) *(u32x4*)(sDf + tid * 4) = bd[s]; *(u32x4*)as_ = ba[s]; } while (0)
        SCAN_LOAD(0, nbeg); SCAN_LOAD(1, nbeg + 1); SCAN_LOAD(2, nbeg + 2);
        __syncthreads();
        SCAN_STAGE(0);
        __syncthreads();
#define SCAN_BODY(s, n) do { \
            { const int np = (n) + 3 <= nlast ? (n) + 3 : nlast; SCAN_LOAD(((s) + 3) & 3, np); } \
            uint4 sw; sw.x = cvt_pk_bf16(st[0][0], st[0][1]); sw.y = cvt_pk_bf16(st[0][2], st[0][3]); sw.z = cvt_pk_bf16(st[1][0], st[1][1]); sw.w = cvt_pk_bf16(st[1][2], st[1][3]); \
            const bf16x8 sb = as_bf8(sw); \
            float* red = sRed + wid * 1024; \
            const bf16x8 v0f = *(const bf16x8*)(vrd), v1f = *(const bf16x8*)(vrd + 64); \
            _Pragma("unroll") for (int qt = 0; qt < 4; ++qt) { const uint2 a0 = *(const uint2*)(qrd + qt * 8448), a1 = *(const uint2*)(qrd + qt * 8448 + 32); \
                f32x4 op = {0.f, 0.f, 0.f, 0.f}; op = mfma16(as_bf8(make_uint4(a0.x, a0.y, a1.x, a1.y)), sb, op); \
                if (qt == (wid & 3)) op = mfma16(*(const bf16x8*)(ard), (wid >> 2) ? v1f : v0f, op); \
                _Pragma("unroll") for (int jj = 0; jj < 4; ++jj) red[(qt * 16 + fq * 4 + jj) * 16 + fr] = op[jj]; } \
            { const f32x4 d0 = *(const f32x4*)(drd), d1 = *(const f32x4*)(drd + 16); \
              f32x4 c = st[0] * d0; c = mfma16(*(const bf16x8*)(krd), v0f, c); st[0] = mfma16(*(const bf16x8*)(krd + 64), v1f, c); \
              f32x4 c2 = st[1] * d1; c2 = mfma16(*(const bf16x8*)(krd + 2304), v0f, c2); st[1] = mfma16(*(const bf16x8*)(krd + 2304 + 64), v1f, c2); } \
            __syncthreads(); \
            { float2 acc = make_float2(0.f, 0.f); \
              _Pragma("unroll") for (int w = 0; w < 8; ++w) { const float2 r = *(const float2*)(sRed + w * 1024 + e2); acc.x += r.x; acc.y += r.y; } \
              if (do_store) *(float2*)(ob + (size_t)(n) * 131072) = acc; } \
            SCAN_STAGE(((s) + 1) & 3); \
            __syncthreads(); } while (0)
        for (int n0 = nbeg; n0 < nbeg + 128; n0 += 4) { SCAN_BODY(0, n0); SCAN_BODY(1, n0 + 1); SCAN_BODY(2, n0 + 2); SCAN_BODY(3, n0 + 3); }
        if (seg == 0 && do_store) { bf16_t* STp = (bf16_t*)(p.ws + OFF_ST) + ((size_t)h * 512 + v0 + fr) * 256 + kw + fq * 4;
            *(uint2*)(STp) = make_uint2(cvt_pk_bf16(st[0][0], st[0][1]), cvt_pk_bf16(st[0][2], st[0][3]));
            *(uint2*)(STp + 16) = make_uint2(cvt_pk_bf16(st[1][0], st[1][1]), cvt_pk_bf16(st[1][2], st[1][3])); }
#undef SCAN_BODY
#undef SCAN_STAGE
#undef SCAN_LOAD
#undef SCAN_LB1
#undef SCAN_ST1
    }
}

__device__ __forceinline__ void gla_onorm(const Params& p, int wv, int nitems) {
    const int tid = opaque_tid(wv), lane = tid & 63, wid = tid >> 6;
    const float* O = (const float*)(p.ws + OFF_A3); const bf16_t* proj = (const bf16_t*)(p.ws + OFF_PROJ); bf16_t* A1 = (bf16_t*)(p.ws + OFF_A1);
    const float* onw = p.in[6];
    const float4 w0 = *(const float4*)(onw + lane * 8), w1 = *(const float4*)(onw + lane * 8 + 4);
    const int nw = gridDim.x * 8;
    for (int item = blockIdx.x * 8 + wid; item < nitems; item += nw) { const size_t t = item >> 2; const int h = item & 3;
        const float4 a = *(const float4*)(O + t * 2048 + h * 512 + lane * 8), b = *(const float4*)(O + t * 2048 + h * 512 + lane * 8 + 4);
        const uint4 g = *(const uint4*)(proj + t * NPROJ + 4096 + h * 512 + lane * 8);
        float ss = a.x * a.x + a.y * a.y + a.z * a.z + a.w * a.w + b.x * b.x + b.y * b.y + b.z * b.z + b.w * b.w;
        ss = wave_sum(ss); const float r = rsqrtf(ss * (1.0f / 512.0f) + 1e-6f);
        float o[8] = {a.x * r * w0.x, a.y * r * w0.y, a.z * r * w0.z, a.w * r * w0.w, b.x * r * w1.x, b.y * r * w1.y, b.z * r * w1.z, b.w * r * w1.w};
        const float gv[8] = {bflo(g.x), bfhi(g.x), bflo(g.y), bfhi(g.y), bflo(g.z), bfhi(g.z), bflo(g.w), bfhi(g.w)};
#pragma unroll
        for (int i = 0; i < 8; ++i) o[i] *= gv[i] * __builtin_amdgcn_rcpf(1.0f + __expf(-gv[i]));
        uint4 w; w.x = pk2(o[0], o[1]); w.y = pk2(o[2], o[3]); w.z = pk2(o[4], o[5]); w.w = pk2(o[6], o[7]);
        *(uint4*)(A1 + t * 2048 + h * 512 + lane * 8) = w; }
}

__device__ __forceinline__ void gla_scanfix(const Params& p, unsigned char* smem, int wv) {
    const int tid = opaque_tid(wv), lane = tid & 63, wid = tid >> 6, fr = lane & 15, fq = lane >> 4;
    const bf16_t* qdec = (const bf16_t*)(p.ws + OFF_QDEC); const bf16_t* ST = (const bf16_t*)(p.ws + OFF_ST);
    float* O = (float*)(p.ws + OFF_A3); const float* decay = (const float*)(p.ws + OFF_DECAY);
    bf16_t* sA = (bf16_t*)smem; float* sP = (float*)(smem + 33792);
    float pr = 1.f; int jdone = 128;
    for (int u = blockIdx.x; u < 512; u += gridDim.x) { const int h = u & 3, n = 128 + (u >> 2);
        if ((gridDim.x & 3) != 0) { pr = 1.f; jdone = 128; }
        if (tid < 256) { const float* dp = decay + (size_t)(h * 256 + jdone) * 256 + tid;
#pragma unroll 8
            for (int j = jdone; j < n; ++j) { pr *= *dp; dp += 256; }
            sP[tid] = pr; }
        jdone = n;
        __syncthreads();
#pragma unroll
        for (int i = 0; i < 4; ++i) { const int row = tid >> 3, c0 = ((tid & 7) + i * 8) * 8;
            const uint4 v = *(const uint4*)(qdec + (size_t)(n * 64 + row) * 1024 + h * 256 + c0);
            const f32x4 p0 = *(const f32x4*)(sP + c0), p1 = *(const f32x4*)(sP + c0 + 4);
            *(uint4*)(sA + row * 264 + c0) = make_uint4(pk2(bflo(v.x) * p0[0], bfhi(v.x) * p0[1]), pk2(bflo(v.y) * p0[2], bfhi(v.y) * p0[3]), pk2(bflo(v.z) * p1[0], bfhi(v.z) * p1[1]), pk2(bflo(v.w) * p1[2], bfhi(v.w) * p1[3])); }
        __syncthreads();
        f32x4 acc[4][4];
#pragma unroll
        for (int vt = 0; vt < 4; ++vt)
#pragma unroll
            for (int qt = 0; qt < 4; ++qt) acc[vt][qt] = (f32x4){0.f, 0.f, 0.f, 0.f};
        const bf16_t* stp = ST + ((size_t)h * 512 + wid * 64 + fr) * 256 + fq * 8;
#pragma unroll 2
        for (int ks = 0; ks < 8; ++ks) { bf16x8 bfr[4];
#pragma unroll
            for (int qt = 0; qt < 4; ++qt) bfr[qt] = *(const bf16x8*)(sA + (qt * 16 + fr) * 264 + ks * 32 + fq * 8);
#pragma unroll
            for (int vt = 0; vt < 4; ++vt) { const bf16x8 a = as_bf8(*(const uint4*)(stp + (size_t)vt * 16 * 256 + ks * 32));
#pragma unroll
                for (int qt = 0; qt < 4; ++qt) acc[vt][qt] = mfma16(a, bfr[qt], acc[vt][qt]); } }
        float* sSq = (float*)(smem + 34816);
        float rsq[4];
#pragma unroll
        for (int qt = 0; qt < 4; ++qt) { float sq = 0.f;
#pragma unroll
            for (int vt = 0; vt < 4; ++vt) { const f32x4 o = *(const f32x4*)(O + (size_t)(n * 64 + qt * 16 + fr) * 2048 + h * 512 + wid * 64 + vt * 16 + fq * 4) + acc[vt][qt]; acc[vt][qt] = o;
                sq += o[0] * o[0] + o[1] * o[1] + o[2] * o[2] + o[3] * o[3]; }
            sq += __shfl_xor(sq, 16); sq += __shfl_xor(sq, 32);
            if (fq == 0) sSq[(qt * 16 + fr) * 8 + wid] = sq; }
        __syncthreads();
#pragma unroll
        for (int qt = 0; qt < 4; ++qt) { const f32x4 s0 = *(const f32x4*)(sSq + (qt * 16 + fr) * 8), s1 = *(const f32x4*)(sSq + (qt * 16 + fr) * 8 + 4);
            rsq[qt] = rsqrtf((s0[0] + s0[1] + s0[2] + s0[3] + s1[0] + s1[1] + s1[2] + s1[3]) * (1.0f / 512.0f) + 1e-6f); }
        { const bf16_t* proj = (const bf16_t*)(p.ws + OFF_PROJ); bf16_t* A1 = (bf16_t*)(p.ws + OFF_A1); const float* onw = p.in[6];
#pragma unroll
          for (int vt = 0; vt < 4; ++vt) { const int vc = wid * 64 + vt * 16 + fq * 4; const f32x4 w4 = *(const f32x4*)(onw + vc);
#pragma unroll
              for (int qt = 0; qt < 4; ++qt) { const size_t t = (size_t)(n * 64 + qt * 16 + fr);
                  const uint2 gv = *(const uint2*)(proj + t * NPROJ + 4096 + h * 512 + vc);
                  const float g0 = bflo(gv.x), g1 = bfhi(gv.x), g2 = bflo(gv.y), g3 = bfhi(gv.y); const f32x4 o = acc[vt][qt] * rsq[qt];
                  *(uint2*)(A1 + t * 2048 + h * 512 + vc) = make_uint2(pk2(o[0] * w4[0] * g0 * __builtin_amdgcn_rcpf(1.0f + __expf(-g0)), o[1] * w4[1] * g1 * __builtin_amdgcn_rcpf(1.0f + __expf(-g1))),
                                                                       pk2(o[2] * w4[2] * g2 * __builtin_amdgcn_rcpf(1.0f + __expf(-g2)), o[3] * w4[3] * g3 * __builtin_amdgcn_rcpf(1.0f + __expf(-g3)))); } } }
        __syncthreads();
    }
    gla_onorm(p, wv, S_ * 2);
}

__device__ __forceinline__ void ffn_fix(const Params& p, int layer, int wv) {
    const bf16_t* halo = (const bf16_t*)(p.ws + OFF_HALO); bf16_t* act = (bf16_t*)(p.ws + OFF_BIG);
    const float* cw = p.in[18] + (size_t)layer * 3 * F2_; const float* cb = p.in[19] + (size_t)layer * F2_;
    const int gsz = gridDim.x * 512;
    for (int item = blockIdx.x * 512 + opaque_tid(wv); item < 704 * 512; item += gsz) { const int cgp = item % 704, rix = item / 704, g = rix >> 1, rr = rix & 1, f0 = cgp * 8;
        const uint4 z = make_uint4(0, 0, 0, 0);
#define HROW(gg, slot, part) (*(const uint4*)(halo + (size_t)(((gg) * 4 + (slot)) * 2 + (part)) * F_ + f0))
        const uint4 a0 = HROW(g, rr, 0), u0 = HROW(g, rr, 1);
        uint4 a1, u1, a2, u2;
        if (rr == 1) { a1 = HROW(g, 0, 0); u1 = HROW(g, 0, 1); if (g > 0) { a2 = HROW(g - 1, 3, 0); u2 = HROW(g - 1, 3, 1); } else { a2 = z; u2 = z; } }
        else if (g > 0) { a1 = HROW(g - 1, 3, 0); u1 = HROW(g - 1, 3, 1); a2 = HROW(g - 1, 2, 0); u2 = HROW(g - 1, 2, 1); }
        else { a1 = z; u1 = z; a2 = z; u2 = z; }
#undef HROW
        const u32 A2[4] = {a2.x, a2.y, a2.z, a2.w}, A1[4] = {a1.x, a1.y, a1.z, a1.w}, A0[4] = {a0.x, a0.y, a0.z, a0.w};
        const u32 U2[4] = {u2.x, u2.y, u2.z, u2.w}, U1[4] = {u1.x, u1.y, u1.z, u1.w}, U0[4] = {u0.x, u0.y, u0.z, u0.w};
        u32 ow[4];
#pragma unroll
        for (int e = 0; e < 4; ++e) { const int fl = f0 + 2 * e, fh = fl + 1;
            const float al = cb[fl] + cw[fl] * bflo(A2[e]) + cw[F2_ + fl] * bflo(A1[e]) + cw[2 * F2_ + fl] * bflo(A0[e]);
            const float ah = cb[fh] + cw[fh] * bfhi(A2[e]) + cw[F2_ + fh] * bfhi(A1[e]) + cw[2 * F2_ + fh] * bfhi(A0[e]);
            const float ul = cb[F_ + fl] + cw[F_ + fl] * bflo(U2[e]) + cw[F2_ + F_ + fl] * bflo(U1[e]) + cw[2 * F2_ + F_ + fl] * bflo(U0[e]);
            const float uh = cb[F_ + fh] + cw[F_ + fh] * bfhi(U2[e]) + cw[F2_ + F_ + fh] * bfhi(U1[e]) + cw[2 * F2_ + F_ + fh] * bfhi(U0[e]);
            ow[e] = pk2(al * __builtin_amdgcn_rcpf(1.0f + __expf(-al)) * ul, ah * __builtin_amdgcn_rcpf(1.0f + __expf(-ah)) * uh); }
        *(uint4*)(act + (size_t)(g * 64 + rr) * F_ + f0) = make_uint4(ow[0], ow[1], ow[2], ow[3]);
    }
}

__device__ __forceinline__ void moba_prep(const Params& p, unsigned char* smem, int wv) {
    const int tid = opaque_tid(wv), lane = tid & 63, wid = tid >> 6, l16 = lane & 15, sub = lane >> 4;
    const bf16_t* raw = (const bf16_t*)(p.ws + OFF_PROJ); bf16_t* qn = (bf16_t*)(p.ws + OFF_A3); bf16_t* kn = (bf16_t*)(p.ws + OFF_KN); bf16_t* vTm = (bf16_t*)(p.ws + OFF_VTM);
    float* kmean = (float*)(p.ws + OFF_KMEAN);
    bf16_t* sV = (bf16_t*)smem; float* sKm = (float*)(smem + 67584);
    { int* cnt = (int*)(p.ws + OFF_CNT); int* ctr = (int*)(p.ws + OFF_CTR);
      for (int e = blockIdx.x * 512 + tid; e < 1024; e += gridDim.x * 512) cnt[e] = 256;
      if (blockIdx.x == 0 && tid == 0) ctr[0] = 0; }
    float qw[8], kwt[8];
#pragma unroll
    for (int e = 0; e < 8; ++e) { qw[e] = p.in[13][l16 * 8 + e] * 0.08838834764831845f; kwt[e] = p.in[10][l16 * 8 + e]; }
    for (int u = blockIdx.x; u < 1024; u += gridDim.x) { const int h = u & 15, j = u >> 4;
#pragma unroll
        for (int it = 0; it < 8; ++it) { const int key = lane + 64 * (wid & 3), dg = it * 2 + (wid >> 2);
            const uint4 v = *(const uint4*)(raw + (size_t)(j * 256 + key) * NPROJ + 4096 + h * 128 + dg * 8);
            bf16_t* d = sV + (dg * 8) * 264 + key;
            d[0] = (bf16_t)(v.x & 0xffff); d[264] = (bf16_t)(v.x >> 16); d[528] = (bf16_t)(v.y & 0xffff); d[792] = (bf16_t)(v.y >> 16);
            d[1056] = (bf16_t)(v.z & 0xffff); d[1320] = (bf16_t)(v.z >> 16); d[1584] = (bf16_t)(v.w & 0xffff); d[1848] = (bf16_t)(v.w >> 16); }
        float ksum[8] = {0.f, 0.f, 0.f, 0.f, 0.f, 0.f, 0.f, 0.f};
#pragma unroll 2
        for (int it = 0; it < 8; ++it) { const size_t t = (size_t)(j * 256 + wid * 32 + it * 4 + sub);
            const uint4 qv = *(const uint4*)(raw + t * NPROJ + h * 128 + l16 * 8), kv = *(const uint4*)(raw + t * NPROJ + 2048 + h * 128 + l16 * 8);
            float q[8] = {bflo(qv.x), bfhi(qv.x), bflo(qv.y), bfhi(qv.y), bflo(qv.z), bfhi(qv.z), bflo(qv.w), bfhi(qv.w)};
            float k[8] = {bflo(kv.x), bfhi(kv.x), bflo(kv.y), bfhi(kv.y), bflo(kv.z), bfhi(kv.z), bflo(kv.w), bfhi(kv.w)};
            float sq = 0.f, sk = 0.f;
#pragma unroll
            for (int e = 0; e < 8; ++e) { sq += q[e] * q[e]; sk += k[e] * k[e]; }
#pragma unroll
            for (int o = 1; o < 16; o <<= 1) { sq += __shfl_xor(sq, o); sk += __shfl_xor(sk, o); }
            const float rq = rsqrtf(sq * (1.0f / 128.0f) + 1e-6f), rk = rsqrtf(sk * (1.0f / 128.0f) + 1e-6f);
#pragma unroll
            for (int e = 0; e < 8; ++e) { q[e] *= rq * qw[e]; k[e] *= rk * kwt[e]; ksum[e] += k[e]; }
            *(uint4*)(qn + ((size_t)h * S_ + t) * 128 + l16 * 8) = make_uint4(pk2(q[0], q[1]), pk2(q[2], q[3]), pk2(q[4], q[5]), pk2(q[6], q[7]));
            *(uint4*)(kn + ((size_t)h * S_ + t) * 128 + l16 * 8) = make_uint4(pk2(k[0], k[1]), pk2(k[2], k[3]), pk2(k[4], k[5]), pk2(k[6], k[7])); }
#pragma unroll
        for (int e = 0; e < 8; ++e) { ksum[e] += __shfl_xor(ksum[e], 16); ksum[e] += __shfl_xor(ksum[e], 32); }
        if (sub == 0) {
#pragma unroll
            for (int e = 0; e < 8; ++e) sKm[wid * 128 + l16 * 8 + e] = ksum[e]; }
        __syncthreads();
        if (tid < 128) { float s = 0.f;
#pragma unroll
            for (int w = 0; w < 8; ++w) s += sKm[w * 128 + tid];
            kmean[(size_t)(h * 64 + j) * 128 + tid] = s * (1.0f / 256.0f); }
#pragma unroll
        for (int it = 0; it < 8; ++it) { const int id = it * 512 + tid, d = id >> 5, part = id & 31;
            *(uint4*)(vTm + ((size_t)(h * 64 + j) * 128 + d) * 256 + part * 8) = *(const uint4*)(sV + d * 264 + part * 8); }
        __syncthreads();
    }
}

__device__ __forceinline__ void moba_gate(const Params& p, unsigned char* smem, int wv) {
    const int tid = opaque_tid(wv), lane = tid & 63, wid = tid >> 6, fr = lane & 15, fq = lane >> 4;
    const bf16_t* qn = (const bf16_t*)(p.ws + OFF_A3); const float* kmean = (const float*)(p.ws + OFF_KMEAN);
    int* cnt = (int*)(p.ws + OFF_CNT); bf16_t* lists = (bf16_t*)(p.ws + OFF_LISTS);
    bf16_t* sKh = (bf16_t*)smem; bf16_t* sKl = (bf16_t*)(smem + 17408);
    for (int u = blockIdx.x; u < 1024; u += gridDim.x) { const int h = u & 15, bb = u >> 4, b = (bb & 48) + ((bb & 16) ? 15 - (bb & 15) : (bb & 15)), ntl = (b + 15) >> 4;
        for (int e = tid; e < ntl * 2048; e += 512) { const int n = e >> 7, d = e & 127; const float km = n < b ? kmean[(size_t)h * 8192 + e] : 0.f;
            const u32 hi = cvt_pk_bf16(km, km) & 0xffffu; const float rem = km - __uint_as_float(hi << 16);
            sKh[n * 136 + d] = (bf16_t)hi; sKl[n * 136 + d] = (bf16_t)(cvt_pk_bf16(rem, rem) & 0xffffu); }
        uint4 qf[2][4];
#pragma unroll
        for (int qt = 0; qt < 2; ++qt)
#pragma unroll
            for (int ks = 0; ks < 4; ++ks) qf[qt][ks] = *(const uint4*)(qn + ((size_t)h * S_ + b * 256 + wid * 32 + qt * 16 + fr) * 128 + ks * 32 + fq * 8);
        __syncthreads();
        float v0[2] = {-INFINITY, -INFINITY}, v1[2] = {-INFINITY, -INFINITY}, v2[2] = {-INFINITY, -INFINITY}; int i0[2] = {255, 255}, i1[2] = {255, 255}, i2[2] = {255, 255};
#define TOP_INS(z, g, n) do { if ((g) > v0[z]) { v2[z] = v1[z]; i2[z] = i1[z]; v1[z] = v0[z]; i1[z] = i0[z]; v0[z] = (g); i0[z] = (n); } else if ((g) > v1[z]) { v2[z] = v1[z]; i2[z] = i1[z]; v1[z] = (g); i1[z] = (n); } else if ((g) > v2[z]) { v2[z] = (g); i2[z] = (n); } } while (0)
        for (int nt = 0; nt < ntl; ++nt) { f32x4 acc[2] = {{0.f, 0.f, 0.f, 0.f}, {0.f, 0.f, 0.f, 0.f}};
#pragma unroll
            for (int ks = 0; ks < 4; ++ks) { const bf16x8 ah = *(const bf16x8*)(sKh + (nt * 16 + fr) * 136 + ks * 32 + fq * 8), al = *(const bf16x8*)(sKl + (nt * 16 + fr) * 136 + ks * 32 + fq * 8);
#pragma unroll
                for (int qt = 0; qt < 2; ++qt) { acc[qt] = mfma16(ah, as_bf8(qf[qt][ks]), acc[qt]); acc[qt] = mfma16(al, as_bf8(qf[qt][ks]), acc[qt]); } }
#pragma unroll
            for (int qt = 0; qt < 2; ++qt)
#pragma unroll
                for (int jj = 0; jj < 4; ++jj) { const int n = nt * 16 + fq * 4 + jj; const float g = n < b ? acc[qt][jj] : -INFINITY; TOP_INS(qt, g, n); } }
#pragma unroll
        for (int qt = 0; qt < 2; ++qt)
#pragma unroll
            for (int o = 16; o <= 32; o <<= 1) { const float pv0 = __shfl_xor(v0[qt], o), pv1 = __shfl_xor(v1[qt], o), pv2 = __shfl_xor(v2[qt], o);
                const int pi0 = __shfl_xor(i0[qt], o), pi1 = __shfl_xor(i1[qt], o), pi2 = __shfl_xor(i2[qt], o);
                TOP_INS(qt, pv0, pi0); TOP_INS(qt, pv1, pi1); TOP_INS(qt, pv2, pi2); }
#undef TOP_INS
        if (fq == 0) {
#pragma unroll
            for (int qt = 0; qt < 2; ++qt) { const int qi = wid * 32 + qt * 16 + fr, t = b * 256 + qi;
                lists[(size_t)(h * 64 + b) * 16384 + qi] = (bf16_t)((t << 2) | 3);
                if (i0[qt] != 255) { const int pos = atomicAdd(&cnt[h * 64 + i0[qt]], 1); lists[(size_t)(h * 64 + i0[qt]) * 16384 + pos] = (bf16_t)((t << 2) | 0); }
                if (i1[qt] != 255) { const int pos = atomicAdd(&cnt[h * 64 + i1[qt]], 1); lists[(size_t)(h * 64 + i1[qt]) * 16384 + pos] = (bf16_t)((t << 2) | 1); }
                if (i2[qt] != 255) { const int pos = atomicAdd(&cnt[h * 64 + i2[qt]], 1); lists[(size_t)(h * 64 + i2[qt]) * 16384 + pos] = (bf16_t)((t << 2) | 2); } } }
        __syncthreads();
    }
}
__device__ __forceinline__ void moba_attn(const Params& p, unsigned char* smem, int wv) {
    const int tid = opaque_tid(wv), lane = tid & 63, wid = tid >> 6, fr = lane & 15, fq = lane >> 4;
    const bf16_t* qn = (const bf16_t*)(p.ws + OFF_A3); const bf16_t* kn = (const bf16_t*)(p.ws + OFF_KN); const bf16_t* vTm = (const bf16_t*)(p.ws + OFF_VTM);
    const int* cntg = (const int*)(p.ws + OFF_CNT); int* ctr = (int*)(p.ws + OFF_CTR); const bf16_t* lists = (const bf16_t*)(p.ws + OFF_LISTS);
    bf16_t* opart = (bf16_t*)(p.ws + OFF_OPART); float2* ml = (float2*)(p.ws + OFF_ML);
    const float* rel_bias = p.in[15];
    bf16_t* sKs = (bf16_t*)smem; bf16_t* sVT = (bf16_t*)(smem + 69632); float* sBias = (float*)(smem + 137216); int* sU = (int*)(smem + 138240);
    for (;;) {
        if (tid == 0) *sU = atomicAdd(ctr, 1);
        __syncthreads();
        const int u = *sU;
        if (u >= 1024) break;
        const int j = u >> 4, h = u & 15;
        int tl = tid; asm volatile("" : "+v"(tl));
#pragma unroll
        for (int it = 0; it < 8; ++it) { const int id = it * 512 + tl;
            { const int key = id >> 4, dg = id & 15; *(uint4*)(sKs + key * 136 + dg * 8) = *(const uint4*)(kn + ((size_t)h * S_ + j * 256 + key) * 128 + dg * 8); }
            { const int d = id >> 5, part = id & 31, rem = d & 31, R = ((d >> 5) * 2 + ((rem >> 2) & 1)) * 16 + (rem >> 3) * 4 + (rem & 3); *(uint4*)(sVT + R * 264 + part * 8) = *(const uint4*)(vTm + ((size_t)(h * 64 + j) * 128 + d) * 256 + part * 8); } }
        if (tl < 129) { int bk = tl; if (tl >= 16) { bk = 16 + (int)(__logf((float)tl * 0.0625f) / 2.0794415416798357f * 16.0f); bk = bk > 31 ? 31 : bk; } sBias[tl] = rel_bias[bk * 16 + h]; }
        __syncthreads();
        const int cnt = cntg[h * 64 + j], npass = (cnt + 255) >> 8;
        const float c128 = sBias[128];
        const bf16_t* L = lists + (size_t)(h * 64 + j) * 16384;
        for (int pass = 0; pass < npass; ++pass) {
            const int base = pass * 256 + wid * 32;
            if (base >= cnt) continue;
            int tq[2], rq[2]; bool valid[2]; uint4 qf[2][4];
#pragma unroll
            for (int qt = 0; qt < 2; ++qt) { const int li = base + qt * 16 + fr; valid[qt] = li < cnt; const u32 e = L[valid[qt] ? li : base]; tq[qt] = (int)(e >> 2); rq[qt] = (int)(e & 3);
#pragma unroll
                for (int ks = 0; ks < 4; ++ks) qf[qt][ks] = *(const uint4*)(qn + ((size_t)h * S_ + tq[qt]) * 128 + ks * 32 + fq * 8); }
            float m[2] = {-1e30f, -1e30f}, l[2] = {0.f, 0.f};
            f32x4 oT[8][2];
#pragma unroll
            for (int dt = 0; dt < 8; ++dt) { oT[dt][0] = (f32x4){0.f, 0.f, 0.f, 0.f}; oT[dt][1] = (f32x4){0.f, 0.f, 0.f, 0.f}; }
            for (int kc = 0; kc < 4; ++kc) {
                if (pass == 0 && kc * 64 > wid * 32 + 31) continue;
                f32x4 sT[4][2];
                { const bf16_t* kp = sKs + (kc * 64 + fr) * 136 + fq * 8;
                  bf16x8 af[2][2];
                  af[0][0] = *(const bf16x8*)(kp); af[0][1] = *(const bf16x8*)(kp + 32);
#pragma unroll
                  for (int st2 = 0; st2 < 8; ++st2) { const int kt = st2 >> 1, kh = (st2 & 1) * 2;
                    if (st2 + 1 < 8) { const int nkt = (st2 + 1) >> 1, nkh = ((st2 + 1) & 1) * 2;
                        af[(st2 + 1) & 1][0] = *(const bf16x8*)(kp + nkt * 16 * 136 + nkh * 32); af[(st2 + 1) & 1][1] = *(const bf16x8*)(kp + nkt * 16 * 136 + (nkh + 1) * 32); }
                    if (kh == 0) { sT[kt][0] = (f32x4){0.f, 0.f, 0.f, 0.f}; sT[kt][1] = (f32x4){0.f, 0.f, 0.f, 0.f}; }
#pragma unroll
                    for (int k2 = 0; k2 < 2; ++k2) { sT[kt][0] = mfma16(af[st2 & 1][k2], as_bf8(qf[0][kh + k2]), sT[kt][0]); sT[kt][1] = mfma16(af[st2 & 1][k2], as_bf8(qf[1][kh + k2]), sT[kt][1]); } } }
                uint4 pb[2][2];
                const int kmax = j * 256 + kc * 64 + 63;
                const bool far = __all((tq[0] - kmax >= 128) && (tq[1] - kmax >= 128)) != 0;
#pragma unroll
                for (int qt = 0; qt < 2; ++qt) { float cm = -1e30f;
                    if (far) {
#pragma unroll
                        for (int kt = 0; kt < 4; ++kt)
#pragma unroll
                            for (int jj = 0; jj < 4; ++jj) { const float s = sT[kt][qt][jj] + c128; sT[kt][qt][jj] = s; cm = fmaxf(cm, s); }
                    } else {
#pragma unroll
                        for (int kh = 0; kh < 4; kh += 2) { float bv[2][4];
#pragma unroll
                            for (int kt = 0; kt < 2; ++kt)
#pragma unroll
                                for (int jj = 0; jj < 4; ++jj) { int dd = tq[qt] - (j * 256 + kc * 64 + (kh + kt) * 16 + fq * 4 + jj); dd = dd < 0 ? 0 : (dd > 128 ? 128 : dd); bv[kt][jj] = sBias[dd]; }
#pragma unroll
                            for (int kt = 0; kt < 2; ++kt)
#pragma unroll
                                for (int jj = 0; jj < 4; ++jj) { const int dd = tq[qt] - (j * 256 + kc * 64 + (kh + kt) * 16 + fq * 4 + jj);
                                    const float s = dd >= 0 ? sT[kh + kt][qt][jj] + bv[kt][jj] : -1e30f; sT[kh + kt][qt][jj] = s; cm = fmaxf(cm, s); } }
                    }
                    cm = fmaxf(cm, __shfl_xor(cm, 16)); cm = fmaxf(cm, __shfl_xor(cm, 32));
                    const float mn = fmaxf(m[qt], cm), alpha = __expf(m[qt] - mn); m[qt] = mn; float ls = l[qt] * alpha;
                    if (__any(alpha != 1.0f)) {
#pragma unroll
                    for (int dt = 0; dt < 8; ++dt) { oT[dt][qt][0] *= alpha; oT[dt][qt][1] *= alpha; oT[dt][qt][2] *= alpha; oT[dt][qt][3] *= alpha; } }
                    float pv[4][4];
#pragma unroll
                    for (int kt = 0; kt < 4; ++kt)
#pragma unroll
                        for (int jj = 0; jj < 4; ++jj) { pv[kt][jj] = __expf(sT[kt][qt][jj] - mn); ls += pv[kt][jj]; }
                    l[qt] = ls;
#pragma unroll
                    for (int kk = 0; kk < 2; ++kk) pb[qt][kk] = make_uint4(cvt_pk_bf16(pv[2 * kk][0], pv[2 * kk][1]), cvt_pk_bf16(pv[2 * kk][2], pv[2 * kk][3]), cvt_pk_bf16(pv[2 * kk + 1][0], pv[2 * kk + 1][1]), cvt_pk_bf16(pv[2 * kk + 1][2], pv[2 * kk + 1][3])); }
#pragma unroll
                for (int kk = 0; kk < 2; ++kk) { const bf16_t* vp = sVT + fr * 264 + kc * 64 + kk * 32 + fq * 4;
#pragma unroll
                    for (int g = 0; g < 2; ++g) { uint2 vlo[4], vhi[4];
#pragma unroll
                        for (int d4 = 0; d4 < 4; ++d4) { vlo[d4] = *(const uint2*)(vp + (g * 4 + d4) * 16 * 264); vhi[d4] = *(const uint2*)(vp + (g * 4 + d4) * 16 * 264 + 16); }
#pragma unroll
                        for (int d4 = 0; d4 < 4; ++d4) { const int dt = g * 4 + d4; const bf16x8 a = as_bf8(make_uint4(vlo[d4].x, vlo[d4].y, vhi[d4].x, vhi[d4].y));
                            oT[dt][0] = mfma16(a, as_bf8(pb[0][kk]), oT[dt][0]); oT[dt][1] = mfma16(a, as_bf8(pb[1][kk]), oT[dt][1]); } } }
            }
#pragma unroll
            for (int qt = 0; qt < 2; ++qt) { float lt = l[qt]; lt += __shfl_xor(lt, 16); lt += __shfl_xor(lt, 32); const float inv = 1.0f / lt;
                if (valid[qt]) { const size_t slot = (size_t)(h * 4 + rq[qt]) * S_ + tq[qt];
#pragma unroll
                    for (int d2 = 0; d2 < 4; ++d2) *(uint4*)(opart + slot * 128 + d2 * 32 + fq * 8) = make_uint4(cvt_pk_bf16(oT[2 * d2][qt][0] * inv, oT[2 * d2][qt][1] * inv), cvt_pk_bf16(oT[2 * d2][qt][2] * inv, oT[2 * d2][qt][3] * inv),
                                                                                                 cvt_pk_bf16(oT[2 * d2 + 1][qt][0] * inv, oT[2 * d2 + 1][qt][1] * inv), cvt_pk_bf16(oT[2 * d2 + 1][qt][2] * inv, oT[2 * d2 + 1][qt][3] * inv));
                    if (fq == 0) ml[slot] = make_float2(m[qt], lt); } }
        }
        __syncthreads();
    }
}

__device__ __forceinline__ void moba_combine(const Params& p, int wv) {
    const int tid = opaque_tid(wv), lane = tid & 63, wid = tid >> 6, sub = lane >> 4, l16 = lane & 15;
    const bf16_t* opart = (const bf16_t*)(p.ws + OFF_OPART); const float2* ml = (const float2*)(p.ws + OFF_ML); bf16_t* A5 = (bf16_t*)(p.ws + OFF_A3);
    const int nw = gridDim.x * 8;
    for (int g0 = blockIdx.x * 8 + wid; g0 < S_ * 4; g0 += 2 * nw) {
        float2 mlv[2][4]; uint4 xv[2][4]; int tt[2], hh[2], ns[2];
#pragma unroll
        for (int z = 0; z < 2; ++z) { int g = g0 + z * nw; g = g < S_ * 4 ? g : g0; const int t = g >> 2, h = (g & 3) * 4 + sub, own = t >> 8; tt[z] = t; hh[z] = h; ns[z] = own < 3 ? own : 3;
            const size_t slot0 = (size_t)(h * 4) * S_ + t;
#pragma unroll
            for (int r = 0; r < 4; ++r) { const bool ok = (r == 3) || (r < ns[z]);
                if (ok) { mlv[z][r] = ml[slot0 + (size_t)r * S_]; xv[z][r] = *(const uint4*)(opart + (slot0 + (size_t)r * S_) * 128 + l16 * 8); }
                else { mlv[z][r] = make_float2(-1e30f, 0.f); xv[z][r] = make_uint4(0, 0, 0, 0); } } }
#pragma unroll
        for (int z = 0; z < 2; ++z) { if (z == 1 && g0 + nw >= S_ * 4) break;
            float M = -1e30f;
#pragma unroll
            for (int r = 0; r < 4; ++r) M = fmaxf(M, mlv[z][r].x);
            float W = 0.f, o[8] = {0.f, 0.f, 0.f, 0.f, 0.f, 0.f, 0.f, 0.f};
#pragma unroll
            for (int r = 0; r < 4; ++r) { const bool ok = (r == 3) || (r < ns[z]); const float w = ok ? __expf(mlv[z][r].x - M) * mlv[z][r].y : 0.f; W += w;
                const u32 xs[4] = {xv[z][r].x, xv[z][r].y, xv[z][r].z, xv[z][r].w};
#pragma unroll
                for (int e = 0; e < 4; ++e) { o[2 * e] += w * bflo(xs[e]); o[2 * e + 1] += w * bfhi(xs[e]); } }
            const float inv = 1.0f / W;
            *(uint4*)(A5 + (size_t)tt[z] * 2048 + hh[z] * 128 + l16 * 8) = make_uint4(pk2(o[0] * inv, o[1] * inv), pk2(o[2] * inv, o[3] * inv), pk2(o[4] * inv, o[5] * inv), pk2(o[6] * inv, o[7] * inv)); }
    }
}

enum { K_NORM_GK = 0, K_NORM, K_GEMM_BF16, K_GEMM_RES, K_GLA_PREP, K_GLA_SCAN, K_ONORM, K_FIX, K_MOBA_PREP, K_GATE, K_ATTN, K_COMBINE, K_GEMM_ACT, K_SCANFIX };
constexpr int NSTEP = 21;

__global__ void __launch_bounds__(512, 2) fwd_kernel(Params p0) {
    extern __shared__ __attribute__((aligned(16))) unsigned char smem[];
    cg::grid_group grid = cg::this_grid();
    const int wv = __builtin_amdgcn_readfirstlane((int)(threadIdx.x >> 6));
    volatile LAS unsigned* xst = (volatile LAS unsigned*)(smem + LDS_BYTES - 16);
    if (threadIdx.x == 0) { xst[0] = 0u; xst[1] = 0u; }
    __syncthreads();
    const XcdBarrier xb = xcd_barrier_post((unsigned*)(p0.ws + OFF_BAR), xst);
    for (int step = 0; step < NSTEP; ++step) {
        size_t zz = 0; asm volatile("" : "+s"(zz));
        Params p = p0;
#pragma unroll
        for (int i = 0; i < 21; ++i) p.in[i] = p0.in[i] + zz;
        p.out = p0.out + zz; p.ws = p0.ws + zz; p.overlap = p0.overlap;
        bf16_t* W = (bf16_t*)(p.ws + OFF_W);
        float* out = p.out;
        int kind = 0, layer = 0; ConvJob c0 = {nullptr, nullptr, nullptr, 0, 0}, c1 = c0;
        Gemm g = {nullptr, nullptr, S_, 0, 0}; bf16_t* gO = nullptr; const float* gR = nullptr;
        switch (step) {
        case 0: kind = K_NORM_GK; c0 = {p.in[2], p.in[1], W, D_, NPROJ}; break;
        case 1: kind = K_GEMM_BF16; g = {(const bf16_t*)(p.ws + OFF_A3), W, S_, NPROJ, D_}; gO = (bf16_t*)(p.ws + OFF_PROJ); break;
        case 2: kind = K_GLA_PREP; if (!p.overlap) c0 = {p.in[7], nullptr, W, D_, D_}; break;
        case 3: kind = K_GLA_SCAN; break;
        case 4: kind = K_SCANFIX; break;
        case 5: kind = K_GEMM_RES; g = {(const bf16_t*)(p.ws + OFF_A1), p.overlap ? (const bf16_t*)(p.ws + OFF_X0) : W, S_, D_, D_}; gR = p.in[0]; break;
        case 6: kind = K_NORM; if (!p.overlap) c0 = {p.in[17], p.in[16], W, D_, F2_, 1}; break;
        case 7: kind = K_GEMM_ACT; layer = 0; g = {(const bf16_t*)(p.ws + OFF_A3), p.overlap ? (const bf16_t*)(p.ws + OFF_X1) : W, S_, F2_, D_}; break;
        case 8: kind = K_FIX; layer = 0; if (!p.overlap) c0 = {p.in[20], nullptr, W, F_, D_}; break;
        case 9: kind = K_GEMM_RES; g = {(const bf16_t*)(p.ws + OFF_BIG), p.overlap ? (const bf16_t*)(p.ws + OFF_X2) : W, S_, D_, F_}; gR = out; break;
        case 10: kind = K_NORM; if (!p.overlap) { c0 = {p.in[12], p.in[11], W, D_, D_}; c1 = {p.in[9], p.in[8], W + (size_t)D_ * D_, D_, 2 * D_}; } break;
        case 11: kind = K_GEMM_BF16; g = {(const bf16_t*)(p.ws + OFF_A3), p.overlap ? (const bf16_t*)(p.ws + OFF_X3) : W, S_, NPROJ, D_}; gO = (bf16_t*)(p.ws + OFF_PROJ); break;
        case 12: kind = K_MOBA_PREP; break;
        case 13: kind = K_GATE; break;
        case 14: kind = K_ATTN; break;
        case 15: kind = K_COMBINE; c0 = {p.in[14], nullptr, W, D_, D_}; break;
        case 16: kind = K_GEMM_RES; g = {(const bf16_t*)(p.ws + OFF_A3), W, S_, D_, D_}; gR = out; break;
        case 17: kind = K_NORM; c0 = {p.in[17] + (size_t)D_ * F2_, p.in[16] + D_, W, D_, F2_, 1}; break;
        case 18: kind = K_GEMM_ACT; layer = 1; g = {(const bf16_t*)(p.ws + OFF_A3), W, S_, F2_, D_}; break;
        case 19: kind = K_FIX; layer = 1; c0 = {p.in[20] + (size_t)F_ * D_, nullptr, W, F_, D_}; break;
        default: kind = K_GEMM_RES; g = {(const bf16_t*)(p.ws + OFF_BIG), W, S_, D_, F_}; gR = out; break;
        }
#ifdef PROBE_MASK
        const int reps = ((PROBE_MASK >> kind) & 1) ? 2 : 1;
#else
        const int reps = 1;
#endif
        for (int rep = 0; rep < reps; ++rep) {
        if (rep > 0) { grid.sync(); if (kind == K_ATTN && blockIdx.x == 0 && threadIdx.x == 0) *(int*)(p.ws + OFF_CTR) = 0; grid.sync(); }
        const bool last_rep = (rep + 1 == reps);
        conv_job(c0, (float*)smem, wv, (int)blockIdx.x, (int)gridDim.x);
        conv_job(c1, (float*)smem, wv, (int)blockIdx.x, (int)gridDim.x);
        switch (kind) {
        case K_NORM_GK: norm_rows<true>(p.in[0], (bf16_t*)(p.ws + OFF_A3), p.in[3], p.in[1], (float*)(p.ws + OFF_GK1), (float*)smem, wv); break;
        case K_NORM: norm_rows<false>(out, (bf16_t*)(p.ws + OFF_A3), nullptr, nullptr, nullptr, (float*)smem, wv); break;
        case K_GEMM_BF16: { StaticOrder so; so.init(g.M, g.N, (int)gridDim.x, (int)blockIdx.x); EpiBf16P e{gO, g.N}; gemm_phase<EpiBf16P, StaticOrder, false>((PG8_LAS unsigned char*)smem, g, so, e, nullptr, wv); } break;
        case K_GEMM_RES: { StaticOrder so; so.init(g.M, g.N, (int)gridDim.x, (int)blockIdx.x); EpiResF32 e{gR, out, D_}; gemm_phase<EpiResF32, StaticOrder, false>((PG8_LAS unsigned char*)smem, g, so, e, nullptr, wv); } break;
        case K_GLA_PREP: gla_prep(p, smem, wv); break;
        case K_GLA_SCAN: gla_scan(p, smem, wv, last_rep); break;
        case K_SCANFIX: gla_scanfix(p, smem, wv); break;
        case K_ONORM: gla_onorm(p, wv, S_ * 4); break;
        case K_FIX: ffn_fix(p, layer, wv); break;
        case K_GEMM_ACT: { StaticOrder so; so.init(g.M, g.N, (int)gridDim.x, (int)blockIdx.x);
            EpiConvAct e{(bf16_t*)(p.ws + OFF_BIG), (bf16_t*)(p.ws + OFF_HALO), p.in[18] + (size_t)layer * 3 * F2_, p.in[19] + (size_t)layer * F2_};
            gemm_phase<EpiConvAct, StaticOrder, false>((PG8_LAS unsigned char*)smem, g, so, e, nullptr, wv); } break;
        case K_MOBA_PREP: moba_prep(p, smem, wv); break;
        case K_GATE: moba_gate(p, smem, wv); break;
        case K_ATTN: moba_attn(p, smem, wv); break;
        default: moba_combine(p, wv); break;
        }
        }
        if (step + 1 < NSTEP) { if (p.overlap == 0x7fffffffffffffffLL) grid.sync(); else xcd_barrier(xb); }
    }
}

extern "C" void kernel_launch(void* const* d_in, const int* in_sizes, int n_in, void* d_out, int out_size, void* d_ws, size_t ws_size, hipStream_t stream) {
    static int grid_blocks = 0;
    if (grid_blocks == 0) {
        if (n_in != 21 || out_size != S_ * D_ || ws_size < WS_END2 + 16384) { fprintf(stderr, "kernel_launch: unexpected problem (n_in %d out %d ws %zu need %zu)\n", n_in, out_size, ws_size, (size_t)WS_END); grid_blocks = -1; return; }
        int dev = 0, cus = 0, per_cu = 0;
        hipGetDevice(&dev);
        hipDeviceGetAttribute(&cus, hipDeviceAttributeMultiprocessorCount, dev);
        if (hipFuncSetAttribute((const void*)fwd_kernel, hipFuncAttributeMaxDynamicSharedMemorySize, LDS_BYTES) != hipSuccess) { fprintf(stderr, "kernel_launch: hipFuncSetAttribute failed\n"); grid_blocks = -1; return; }
        if (hipOccupancyMaxActiveBlocksPerMultiprocessor(&per_cu, (const void*)fwd_kernel, 512, LDS_BYTES) != hipSuccess || per_cu < 1) { fprintf(stderr, "kernel_launch: occupancy query says %d\n", per_cu); per_cu = 1; (void)hipGetLastError(); }
        grid_blocks = cus * per_cu;
    }
    if (grid_blocks < 0) return;
    Params p{};
    for (int i = 0; i < 21; ++i) p.in[i] = (const float*)d_in[i];
    p.out = (float*)d_out; p.ws = (unsigned char*)d_ws; p.overlap = 0;
    if (hipMemsetAsync((char*)d_ws + OFF_BAR, 0, XCD_BAR_WORDS * 4, stream) != hipSuccess) { fprintf(stderr, "kernel_launch: memset failed\n"); return; }
    void* args[] = {&p};
    hipError_t e = hipLaunchCooperativeKernel((const void*)fwd_kernel, dim3(grid_blocks), dim3(512), args, LDS_BYTES, stream);
    if (e != hipSuccess) fprintf(stderr, "cooperative launch failed: %s (grid %d)\n", hipGetErrorString(e), grid_blocks);
}
```
